# Optimizing an MI355X kernel written in HIP

```python
import math
import jax, jax.numpy as jnp
from jax import lax
import numpy as np

D_MODEL = 1024
BATCH = 2
SEQ = 8192
DEPTH = 1

MEM_LEN = 256
EPS = 1e-6
D_MIX = D_MODEL
D_CONV = D_MIX // 2
CONV_HEADS = 8
CONV_WIDTH = 31
D_SSM = D_MIX - D_CONV
SSM_GROUP = 16
N_SSM_GROUPS = D_SSM // SSM_GROUP
SSM_STATE = 64
N_XHEADS = 4
XHEAD_DIM = D_MODEL // N_XHEADS
N_EXPERT_GROUPS = 4
EXPERTS_PER_GROUP = 8
N_EXPERTS = N_EXPERT_GROUPS * EXPERTS_PER_GROUP
TOP_K = 2
D_EXPERT = D_MODEL // 2
MOE_BLOCK = 128

kernel_name = "hymba_conformer_s5_hmoe_block"


def rms_norm(x, w):
    x32 = x.astype(jnp.float32)
    y = x32 * lax.rsqrt(jnp.mean(x32 * x32, axis=-1, keepdims=True) + EPS)
    return (y * w.astype(jnp.float32)).astype(x.dtype)


def conformer_conv(a, g, conv_w, conv_b, ln_w, ln_b):
    v = a * jax.nn.sigmoid(g)
    c = v.shape[-1]
    v = lax.conv_general_dilated(
        v, conv_w[:, None, :].astype(v.dtype), window_strides=(1,),
        padding=[(CONV_WIDTH - 1, 0)], dimension_numbers=('NWC', 'WIO', 'NWC'),
        feature_group_count=c) + conv_b.astype(v.dtype)
    v32 = v.astype(jnp.float32)
    mu = jnp.mean(v32, axis=-1, keepdims=True)
    var = jnp.mean(jnp.square(v32 - mu), axis=-1, keepdims=True)
    v32 = (v32 - mu) * lax.rsqrt(var + EPS) * ln_w.astype(jnp.float32) + ln_b.astype(jnp.float32)
    return jax.nn.silu(v32).astype(a.dtype)


def _diag_combine(e1, e2):
    a1, b1 = e1
    a2, b2 = e2
    return a1 * a2, a2 * b1 + b2


def s5_mixer(u, A_re, A_im, log_dt, B_re, B_im, C_re, C_im, D, glu_w):
    bsz, s, _ = u.shape
    u32 = u.astype(jnp.float32).reshape(bsz, s, N_SSM_GROUPS, SSM_GROUP)
    lam = lax.complex(A_re.astype(jnp.float32), A_im.astype(jnp.float32))
    dt = jnp.exp(log_dt.astype(jnp.float32))[:, None]
    a_bar = jnp.exp(lam * dt)
    b = lax.complex(B_re.astype(jnp.float32), B_im.astype(jnp.float32))
    b_bar = ((a_bar - 1.0) / lam)[..., None] * b
    bu = jnp.einsum('bsgc,gpc->bsgp', u32.astype(jnp.complex64), b_bar)
    a_seq = jnp.broadcast_to(a_bar, bu.shape)
    _, states = lax.associative_scan(_diag_combine, (a_seq, bu), axis=1)
    c = lax.complex(C_re.astype(jnp.float32), C_im.astype(jnp.float32))
    y = jnp.einsum('bsgp,gcp->bsgc', states, c).real + D.astype(jnp.float32) * u32
    y = jax.nn.gelu(y)
    ab = jnp.einsum('bsgc,gce->bsge', y, glu_w.astype(jnp.float32))
    out = ab[..., :SSM_GROUP] * jax.nn.sigmoid(ab[..., SSM_GROUP:])
    return out.reshape(bsz, s, D_SSM).astype(u.dtype)


def memory_cross_attention(h, m, wq, wk, wv, wo):
    bsz, s, _ = h.shape
    mlen = m.shape[1]
    q = (h @ wq).reshape(bsz, s, N_XHEADS, XHEAD_DIM).astype(jnp.float32)
    k = (m @ wk).reshape(bsz, mlen, N_XHEADS, XHEAD_DIM).astype(jnp.float32)
    v = (m @ wv).reshape(bsz, mlen, N_XHEADS, XHEAD_DIM).astype(jnp.float32)
    scores = jnp.einsum('bshd,bmhd->bhsm', q, k) * (XHEAD_DIM ** -0.5)
    p = jax.nn.softmax(scores, axis=-1)
    o = jnp.einsum('bhsm,bmhd->bshd', p, v).reshape(bsz, s, D_MODEL).astype(h.dtype)
    return o @ wo


def hierarchical_moe(h, wg, bg, we, be, w1, w3, w2):
    bsz, s, d = h.shape
    t = bsz * s
    xt = h.reshape(t, d)
    x32 = xt.astype(jnp.float32)
    g_probs = jax.nn.softmax(x32 @ wg.astype(jnp.float32) + bg.astype(jnp.float32), axis=-1)
    g_w, g_idx = lax.top_k(g_probs, 1)
    e_logits = (x32 @ we.astype(jnp.float32)).reshape(t, N_EXPERT_GROUPS, EXPERTS_PER_GROUP)
    e_logits = e_logits + be.astype(jnp.float32)
    e_logits = e_logits[jnp.arange(t), g_idx[:, 0]]
    top_l, top_i = lax.top_k(e_logits, TOP_K)
    gates = g_w * jax.nn.softmax(top_l, axis=-1)
    expert = g_idx * EPG_CONST() + top_i

    n_assign = t * TOP_K
    e_flat = expert.reshape(n_assign).astype(jnp.int32)
    gate_flat = gates.reshape(n_assign)
    tok_flat = jnp.arange(n_assign, dtype=jnp.int32) // TOP_K
    order = jnp.argsort(e_flat)
    e_sorted = e_flat[order]
    counts = jnp.bincount(e_flat, length=N_EXPERTS).astype(jnp.int32)
    padded = (counts + MOE_BLOCK - 1) // MOE_BLOCK * MOE_BLOCK
    start = jnp.cumsum(counts) - counts
    pstart = jnp.cumsum(padded) - padded
    rank = jnp.arange(n_assign, dtype=jnp.int32) - start[e_sorted]
    slot = pstart[e_sorted] + rank
    n_blocks = -(-n_assign // MOE_BLOCK) + N_EXPERTS
    cap = n_blocks * MOE_BLOCK
    slot_tok = jnp.full((cap,), t, jnp.int32).at[slot].set(tok_flat[order])
    slot_gate = jnp.zeros((cap,), jnp.float32).at[slot].set(gate_flat[order])
    block_start = jnp.arange(n_blocks, dtype=jnp.int32) * MOE_BLOCK
    pend = pstart + padded
    block_expert = jnp.minimum(
        jnp.sum((block_start[:, None] >= pend[None, :]).astype(jnp.int32), axis=1), N_EXPERTS - 1)

    x_pad = jnp.concatenate([xt, jnp.zeros((1, d), xt.dtype)], axis=0)
    xb = x_pad[slot_tok].reshape(n_blocks, MOE_BLOCK, d)

    def expert_block(args):
        xblk, e = args
        hid = jax.nn.silu(xblk @ w1[e]) * (xblk @ w3[e])
        return hid @ w2[e]

    yb = lax.map(expert_block, (xb, block_expert))
    y = yb.reshape(cap, d) * slot_gate[:, None].astype(yb.dtype)
    out = jnp.zeros((t + 1, d), y.dtype).at[slot_tok].add(y)[:t]
    return out.reshape(bsz, s, d).astype(h.dtype)


def EPG_CONST():
    return EXPERTS_PER_GROUP


def setup_inputs(seed: int = 0) -> dict:
    key = jax.random.key(seed)
    ks = jax.random.split(key, 40)
    L, D = DEPTH, D_MODEL
    G, P, c = N_SSM_GROUPS, SSM_STATE, SSM_GROUP
    f32 = jnp.float32

    def nrm(k, shape, scale):
        return jax.random.normal(k, shape, f32) * scale

    def gain(k, shape):
        return 1.0 + 0.05 * jax.random.normal(k, shape, f32)

    n_idx = jnp.arange(P, dtype=f32)
    return {
        "x": nrm(ks[0], (BATCH, SEQ, D), 1.0),
        "mem": nrm(ks[1], (BATCH, MEM_LEN, D), 1.0),
        "norm_mix_w": gain(ks[2], (L, D)),
        "w_in": nrm(ks[3], (L, D, 2 * D_CONV + D_SSM), D ** -0.5),
        "conv_w": nrm(ks[4], (L, CONV_WIDTH, D_CONV), CONV_WIDTH ** -0.5),
        "conv_b": nrm(ks[5], (L, D_CONV), 0.02),
        "conv_ln_w": gain(ks[6], (L, D_CONV)),
        "conv_ln_b": nrm(ks[7], (L, D_CONV), 0.02),
        "ssm_A_re": -0.5 + 0.01 * jax.random.normal(ks[8], (L, G, P), f32),
        "ssm_A_im": math.pi * n_idx + 0.01 * jax.random.normal(ks[9], (L, G, P), f32),
        "ssm_log_dt": jax.random.uniform(ks[10], (L, G), f32, math.log(1e-3), math.log(1e-1)),
        "ssm_B_re": nrm(ks[11], (L, G, P, c), (2 * c) ** -0.5),
        "ssm_B_im": nrm(ks[12], (L, G, P, c), (2 * c) ** -0.5),
        "ssm_C_re": nrm(ks[13], (L, G, c, P), (2 * P) ** -0.5),
        "ssm_C_im": nrm(ks[14], (L, G, c, P), (2 * P) ** -0.5),
        "ssm_D": 1.0 + 0.1 * jax.random.normal(ks[15], (L, G, c), f32),
        "ssm_glu_w": nrm(ks[16], (L, G, c, 2 * c), c ** -0.5),
        "w_out": nrm(ks[17], (L, D_MIX, D), D_MIX ** -0.5),
        "norm_x_w": gain(ks[18], (L, D)),
        "norm_mem_w": gain(ks[19], (L, D)),
        "xq_w": nrm(ks[20], (L, D, D), D ** -0.5),
        "xk_w": nrm(ks[21], (L, D, D), D ** -0.5),
        "xv_w": nrm(ks[22], (L, D, D), D ** -0.5),
        "xo_w": nrm(ks[23], (L, D, D), D ** -0.5),
        "norm_ffn_w": gain(ks[24], (L, D)),
        "router_group_w": nrm(ks[25], (L, D, N_EXPERT_GROUPS), D ** -0.5),
        "router_group_b": nrm(ks[26], (L, N_EXPERT_GROUPS), 0.01),
        "router_expert_w": nrm(ks[27], (L, D, N_EXPERTS), D ** -0.5),
        "router_expert_b": nrm(ks[28], (L, N_EXPERT_GROUPS, EXPERTS_PER_GROUP), 0.01),
        "moe_w1": nrm(ks[29], (L, N_EXPERTS, D, D_EXPERT), D ** -0.5),
        "moe_w3": nrm(ks[30], (L, N_EXPERTS, D, D_EXPERT), D ** -0.5),
        "moe_w2": nrm(ks[31], (L, N_EXPERTS, D_EXPERT, D), D_EXPERT ** -0.5),
        "final_norm_w": gain(ks[32], (D,)),
    }


def reference(x, mem, norm_mix_w, w_in, conv_w, conv_b, conv_ln_w, conv_ln_b,
              ssm_A_re, ssm_A_im, ssm_log_dt, ssm_B_re, ssm_B_im, ssm_C_re, ssm_C_im,
              ssm_D, ssm_glu_w, w_out, norm_x_w, norm_mem_w, xq_w, xk_w, xv_w, xo_w,
              norm_ffn_w, router_group_w, router_group_b, router_expert_w, router_expert_b,
              moe_w1, moe_w3, moe_w2, final_norm_w):
    h = x
    for l in range(DEPTH):
        hn = rms_norm(h, norm_mix_w[l])
        proj = hn @ w_in[l]
        conv_a = proj[..., :D_CONV]
        conv_g = proj[..., D_CONV:2 * D_CONV]
        ssm_u = proj[..., 2 * D_CONV:]
        y_conv = conformer_conv(conv_a, conv_g, conv_w[l], conv_b[l], conv_ln_w[l], conv_ln_b[l])
        y_ssm = s5_mixer(ssm_u, ssm_A_re[l], ssm_A_im[l], ssm_log_dt[l], ssm_B_re[l], ssm_B_im[l],
                         ssm_C_re[l], ssm_C_im[l], ssm_D[l], ssm_glu_w[l])
        h = h + jnp.concatenate([y_conv, y_ssm], axis=-1) @ w_out[l]
        h = h + memory_cross_attention(rms_norm(h, norm_x_w[l]), rms_norm(mem, norm_mem_w[l]),
                                       xq_w[l], xk_w[l], xv_w[l], xo_w[l])
        h = h + hierarchical_moe(rms_norm(h, norm_ffn_w[l]), router_group_w[l], router_group_b[l],
                                 router_expert_w[l], router_expert_b[l],
                                 moe_w1[l], moe_w3[l], moe_w2[l])
    return rms_norm(h, final_norm_w)
```

```cpp
#include <hip/hip_runtime.h>
#include <cstdio>
#include <cstdint>

#define LAS __attribute__((address_space(3)))
#define GAS __attribute__((address_space(1)))
#define CAS __attribute__((address_space(4)))
typedef unsigned short bf16;
typedef short bf16x8 __attribute__((ext_vector_type(8)));
typedef float f32x4 __attribute__((ext_vector_type(4)));
typedef float f32x2 __attribute__((ext_vector_type(2)));
typedef unsigned u32x4 __attribute__((ext_vector_type(4)));
typedef unsigned u32x2 __attribute__((ext_vector_type(2)));

#ifndef MK_PER_PHASE
#define MK_PER_PHASE 0
#endif

constexpr int NB = 2, SEQ = 8192, D = 1024, T = NB * SEQ, MEML = 256, TM = NB * MEML;
constexpr int DCONV = 512, CWID = 31, NG = 32, SGC = 16, NP = 64, NH = 4, HD = 256, NE = 32, EPG = 8, NGRP = 4, DE = 512;
constexpr int CH = 32, NCH = SEQ / CH, KE = CH * SGC, KY = KE + 2 * NP;
constexpr int CAP = 40960;
constexpr int NCOLR = 36;
constexpr float EPS = 1e-6f;
constexpr int NWAVES = 8, NTHR = 512, NPHASE = 13;

constexpr size_t MiB = 1u << 20, KiB = 1024;
constexpr size_t WS_CTL = 0, CTL_ZERO_BYTES = 32 * KiB;
constexpr int CW_BAR = 1024;
constexpr size_t WS_HIST = 1 * MiB, WS_TPREF = WS_HIST + 32 * KiB, WS_TOKE = WS_HIST + 64 * KiB, WS_TOKG = WS_HIST + 192 * KiB, WS_TOKS = WS_HIST + 320 * KiB,
                 WS_RSTD3 = WS_HIST + 448 * KiB, WS_SGATE = WS_HIST + 512 * KiB;
constexpr size_t WS_RS1 = 2 * MiB, WS_KMAT = 3 * MiB;
constexpr size_t WS_WIN = 8 * MiB, WS_WOUT = 11 * MiB, WS_WQ = 13 * MiB, WS_WKV = 15 * MiB, WS_WO = 19 * MiB, WS_TOEP = 21 * MiB, WS_ETAB = 41 * MiB, WS_GLUBT = 46 * MiB,
                 WS_MEMN = 47 * MiB, WS_KPROJ = 48 * MiB, WS_VT = 49 * MiB;
constexpr size_t WS_WUP = 50 * MiB, WS_WDN = 114 * MiB;
constexpr size_t WS_ACT = 146 * MiB;
constexpr size_t WS_HN = WS_ACT, WS_VBUF = WS_ACT + 32 * MiB, WS_UG = WS_ACT + 48 * MiB, WS_CONCAT = WS_ACT + 68 * MiB, WS_G = WS_ACT + 100 * MiB;
constexpr size_t WS_H1B = WS_ACT, WS_QBUF = WS_ACT + 32 * MiB, WS_PBUF = WS_ACT + 68 * MiB, WS_OBUF = WS_ACT + 100 * MiB;
constexpr size_t WS_XG = WS_ACT, WS_HID = WS_ACT + 80 * MiB;
constexpr size_t WS_END = 280 * MiB;
static_assert(WS_G + (size_t)T * 512 * 2 <= WS_END && WS_OBUF + (size_t)T * D * 2 <= WS_END && WS_HID + (size_t)CAP * DE * 2 <= WS_END && WS_UG + (size_t)NG * NB * NCH * KY * 2 <= WS_CONCAT, "d_ws map");

constexpr int RING_BYTES = 131072, EXT_OFF = RING_BYTES, EXT_BYTES = 16384, LCTL_OFF = EXT_OFF + EXT_BYTES, LDS_BYTES = LCTL_OFF + 512;

#define LDS_WAIT() asm volatile("s_waitcnt lgkmcnt(0)" ::: "memory")
#define VM_WAIT() asm volatile("s_waitcnt vmcnt(0)" ::: "memory")
__device__ __forceinline__ unsigned f2bf(float f) { unsigned u = __builtin_bit_cast(unsigned, f); return (u + 0x7fffu + ((u >> 16) & 1u)) >> 16; }
__device__ __forceinline__ unsigned pk2(float lo, float hi) { return f2bf(lo) | (f2bf(hi) << 16); }
__device__ __forceinline__ float bf2f(unsigned h) { return __builtin_bit_cast(float, h << 16); }
__device__ __forceinline__ float bflo(unsigned w) { return __builtin_bit_cast(float, w << 16); }
__device__ __forceinline__ float bfhi(unsigned w) { return __builtin_bit_cast(float, w & 0xffff0000u); }
__device__ __forceinline__ unsigned cvt_pk_bf16(float lo, float hi) { unsigned r; asm volatile("v_cvt_pk_bf16_f32 %0, %1, %2" : "=v"(r) : "v"(lo), "v"(hi)); return r; }
__device__ __forceinline__ u32x4 pack8(const f32x4 a, const f32x4 b) { u32x4 w; w.x = cvt_pk_bf16(a[0], a[1]); w.y = cvt_pk_bf16(a[2], a[3]); w.z = cvt_pk_bf16(b[0], b[1]); w.w = cvt_pk_bf16(b[2], b[3]); return w; }
__device__ __forceinline__ float sigmoidf_(float x) { return __builtin_amdgcn_rcpf(1.0f + __expf(-x)); }
__device__ __forceinline__ f32x4 sig4(f32x4 x) { f32x4 r; r[0] = sigmoidf_(x[0]); r[1] = sigmoidf_(x[1]); r[2] = sigmoidf_(x[2]); r[3] = sigmoidf_(x[3]); return r; }
__device__ __forceinline__ float gelu_tanh(float x) { const float z = 0.7978845608028654f * (x + 0.044715f * x * x * x); const float th = 1.0f - 2.0f * __builtin_amdgcn_rcpf(1.0f + __expf(2.0f * z)); return 0.5f * x * (1.0f + th); }
__device__ __forceinline__ float wave_sum(float v) {
#pragma unroll
    for (int o = 1; o < 64; o <<= 1) v += __shfl_xor(v, o);
    return v;
}

namespace pg8 {
#define PG8_LAS __attribute__((address_space(3)))
typedef unsigned short bf16_t;
constexpr int BM = 256, BK = 64, HALF = 128, HTB = HALF * BK * 2  , STAGE_BYTES = 8 * HTB, NXCD = 8, WGM = 8;
__host__ __device__ __forceinline__ int lds_byte(int r, int c) { const int st = (r >> 4) * 2 + (c >> 5), rr = r & 15, cc = c & 31, ob = rr * 64 + cc * 2; return st * 1024 + (ob ^ (((ob >> 9) & 1) << 5)); }
__host__ __device__ __forceinline__ void stage_rc(int b, int& R, int& C) { const int st = b / 1024, sb = b % 1024, swz = sb ^ (((sb >> 9) & 1) << 5); R = (st >> 1) * 16 + swz / 64; C = (st & 1) * 32 + (swz % 64) / 2; }
__host__ __device__ __forceinline__ int perm32(int rho) { const int n = rho >> 4, i = rho & 15; return 8 * (i >> 2) + 4 * n + (i & 3); }

struct Unit { int pm, pn; long long aoff, boff; };
struct Gemm { const bf16_t* A; const bf16_t* Bt; int lda, ldb, K; };

__device__ __forceinline__ void static_unit(int L, int nM, int nN, int& pm, int& pn) {
    const int nwg = nM * nN; int wgid = L; { const int q = nwg / NXCD, r = nwg % NXCD, xcd = wgid % NXCD, off = wgid / NXCD; wgid = (xcd < r ? xcd * (q + 1) : r * (q + 1) + (xcd - r) * q) + off; }
    const int nig = WGM * nN, gid = wgid / nig, fm = gid * WGM, gsz = (nM - fm) < WGM ? (nM - fm) : WGM;
    pm = fm + ((wgid % nig) % gsz); pn = (wgid % nig) / gsz;
}
template <class Epi, class Sched, bool ALIGN_EPI = false, bool SP2 = false>
__device__ __forceinline__ void gemm_phase(PG8_LAS unsigned char* lds, const Gemm g, const Sched& S, const Epi& E) {
    int tid_ = threadIdx.x; asm volatile("" : "+v"(tid_));
    const int tid = tid_, wid = __builtin_amdgcn_readfirstlane(tid >> 6), lane = tid & 63, wr = wid >> 2, wc = wid & 3, fr = lane & 15, fq = lane >> 4;
    const int K = g.K, nt = K / BK;
    unsigned voffA[2], voffB[2];
#pragma unroll
    for (int i = 0; i < 2; ++i) { int R, C; stage_rc(tid * 16 + i * 8192, R, C); const int Rb = Epi::PERM ? ((R & ~31) + perm32(R & 31)) : R;
        voffA[i] = (unsigned)(R * g.lda + C) * 2u; voffB[i] = (unsigned)(Rb * g.ldb + C) * 2u; }
    const size_t kstep = (size_t)(BK * 2);
    const size_t hstepA = (size_t)HALF * g.lda * 2, hstepB = (size_t)HALF * g.ldb * 2;
    const unsigned ldsw = (unsigned)wid * 1024u;
    const int aoff = lds_byte(wr * 64 + fr, fq * 8), boff = lds_byte(wc * 32 + fr, fq * 8);
#define PG8_SA(b, h) (((b) * 2 + (h)) * HTB)
#define PG8_SB(b, h) ((4 + (b) * 2 + (h)) * HTB)
#define PG8_STAGE(bufoff, gbase, voff) do { _Pragma("unroll") for (int _i = 0; _i < 2; ++_i) \
        __builtin_amdgcn_global_load_lds((const unsigned*)((const char*)(gbase) + (voff)[_i]), (PG8_LAS unsigned*)(lds + (bufoff) + ldsw + _i * 8192), 16, 0, 0); } while (0)
#define PG8_LDA(dst, b, h) do { _Pragma("unroll") for (int m = 0; m < 4; ++m) _Pragma("unroll") for (int k = 0; k < 2; ++k) dst[m][k] = *(const PG8_LAS bf16x8*)(lds + PG8_SA(b, h) + aoff + m * 2048 + k * 1024); } while (0)
#define PG8_LDB(dst, b, h) do { _Pragma("unroll") for (int n = 0; n < 2; ++n) _Pragma("unroll") for (int k = 0; k < 2; ++k) dst[n][k] = *(const PG8_LAS bf16x8*)(lds + PG8_SB(b, h) + boff + n * 2048 + k * 1024); } while (0)
#define PG8_MMA(ai, bj, At, Bt) do { __builtin_amdgcn_s_setprio(1); _Pragma("unroll") for (int m = 0; m < 4; ++m) _Pragma("unroll") for (int n = 0; n < 2; ++n) _Pragma("unroll") for (int k = 0; k < 2; ++k) \
        acc[ai][bj][m][n] = __builtin_amdgcn_mfma_f32_16x16x32_bf16(Bt[n][k], At[m][k], acc[ai][bj][m][n], 0, 0, 0); __builtin_amdgcn_s_setprio(0); } while (0)
#define PG8_WAIT_V(n) asm volatile("s_waitcnt vmcnt(" #n ")" ::: "memory")
#define PG8_WAIT_L(n) asm volatile("s_waitcnt lgkmcnt(" #n ")" ::: "memory")
#define PG8_BAR __builtin_amdgcn_s_barrier()
#define PG8_SCHED __builtin_amdgcn_sched_barrier(0)
    Unit cur, nxt; int ui = 0;
    if (!S.next(0, cur)) return;
    f32x4 acc[2][2][4][2];
#pragma unroll
    for (int a = 0; a < 2; ++a)
#pragma unroll
        for (int b = 0; b < 2; ++b)
#pragma unroll
            for (int m = 0; m < 4; ++m)
#pragma unroll
                for (int n = 0; n < 2; ++n) acc[a][b][m][n] = (f32x4){0.f, 0.f, 0.f, 0.f};
    bf16x8 At[4][2], B0[2][2], B1[2][2];
    const char* cA = (const char*)g.A + cur.aoff; const char* cB = (const char*)g.Bt + cur.boff;
    S.a_ready(cur);
    if constexpr (SP2) {
        PG8_STAGE(PG8_SB(0, 0), cB, voffB); PG8_STAGE(PG8_SB(0, 1), cB + hstepB, voffB); PG8_STAGE(PG8_SA(0, 0), cA, voffA); PG8_STAGE(PG8_SA(0, 1), cA + hstepA, voffA);
        if (wr == 1) PG8_BAR;
        PG8_WAIT_V(2); PG8_BAR;
        PG8_STAGE(PG8_SB(1, 0), cB + kstep, voffB); PG8_STAGE(PG8_SA(1, 0), cA + kstep, voffA); PG8_STAGE(PG8_SB(1, 1), cB + hstepB + kstep, voffB);
        PG8_WAIT_V(6); PG8_BAR;
    } else {
        PG8_STAGE(PG8_SB(0, 0), cB, voffB); PG8_STAGE(PG8_SA(0, 0), cA, voffA); PG8_STAGE(PG8_SB(0, 1), cB + hstepB, voffB); PG8_STAGE(PG8_SA(0, 1), cA + hstepA, voffA);
        if (wr == 1) PG8_BAR;
        PG8_WAIT_V(4); PG8_BAR;
        PG8_STAGE(PG8_SB(1, 0), cB + kstep, voffB); PG8_STAGE(PG8_SA(1, 0), cA + kstep, voffA); PG8_STAGE(PG8_SB(1, 1), cB + hstepB + kstep, voffB);
        PG8_WAIT_V(6); PG8_BAR;
    }
    for (;;) {
        const bool has_next = S.next(ui + 1, nxt);
        const char* nA = has_next ? (const char*)g.A + nxt.aoff : cA; const char* nB = has_next ? (const char*)g.Bt + nxt.boff : cB;
        for (int t = 0; t < nt; t += 2) {
            const bool last = (t == nt - 2);
            const char* a1 = cA + (size_t)(t + 1) * kstep;
            const char* a2 = last ? nA : cA + (size_t)(t + 2) * kstep; const char* b2 = last ? nB : cB + (size_t)(t + 2) * kstep;
            const char* a3 = a2 + kstep; const char* b3 = b2 + kstep;
            if (last && has_next) S.a_ready(nxt);
            if constexpr (SP2) {
            PG8_LDB(B0, 0, 0); PG8_LDB(B1, 0, 1); PG8_SCHED; PG8_LDA(At, 0, 0); PG8_STAGE(PG8_SA(1, 1), a1 + hstepA, voffA);
            PG8_WAIT_V(8); PG8_WAIT_L(0); PG8_BAR; PG8_MMA(0, 0, At, B0); PG8_MMA(0, 1, At, B1); PG8_BAR; PG8_SCHED;
            PG8_LDA(At, 0, 1); PG8_STAGE(PG8_SB(0, 0), b2, voffB); PG8_STAGE(PG8_SB(0, 1), b2 + hstepB, voffB); PG8_STAGE(PG8_SA(0, 0), a2, voffA);
            PG8_WAIT_V(8); PG8_WAIT_L(0); PG8_BAR; PG8_MMA(1, 0, At, B0); PG8_MMA(1, 1, At, B1); PG8_BAR; PG8_SCHED;
            PG8_LDB(B0, 1, 0); PG8_LDB(B1, 1, 1); PG8_SCHED; PG8_LDA(At, 1, 0); PG8_STAGE(PG8_SA(0, 1), a2 + hstepA, voffA);
            PG8_WAIT_V(8); PG8_WAIT_L(0); PG8_BAR; PG8_MMA(0, 0, At, B0); PG8_MMA(0, 1, At, B1); PG8_BAR; PG8_SCHED;
            PG8_LDA(At, 1, 1); PG8_STAGE(PG8_SB(1, 0), b3, voffB); PG8_STAGE(PG8_SB(1, 1), b3 + hstepB, voffB); PG8_STAGE(PG8_SA(1, 0), a3, voffA);
            PG8_WAIT_V(8); PG8_WAIT_L(0); PG8_BAR; PG8_MMA(1, 0, At, B0); PG8_MMA(1, 1, At, B1); PG8_BAR; PG8_SCHED;
            } else {
            PG8_LDB(B0, 0, 0); PG8_SCHED; PG8_LDA(At, 0, 0); PG8_STAGE(PG8_SA(1, 1), a1 + hstepA, voffA);
            PG8_WAIT_L(8); PG8_BAR; PG8_WAIT_L(0); PG8_MMA(0, 0, At, B0); PG8_BAR; PG8_SCHED;
            PG8_LDB(B1, 0, 1); PG8_STAGE(PG8_SB(0, 0), b2, voffB);
            PG8_BAR; PG8_WAIT_L(0); PG8_MMA(0, 1, At, B1); PG8_BAR;
            PG8_LDA(At, 0, 1); PG8_STAGE(PG8_SA(0, 0), a2, voffA);
            PG8_BAR; PG8_WAIT_L(0); PG8_MMA(1, 0, At, B0); PG8_BAR; PG8_SCHED;
            PG8_STAGE(PG8_SB(0, 1), b2 + hstepB, voffB);
            PG8_WAIT_V(6); PG8_BAR; PG8_MMA(1, 1, At, B1); PG8_BAR;
            PG8_LDB(B0, 1, 0); PG8_SCHED; PG8_LDA(At, 1, 0); PG8_STAGE(PG8_SA(0, 1), a2 + hstepA, voffA);
            PG8_WAIT_L(8); PG8_BAR; PG8_WAIT_L(0); PG8_MMA(0, 0, At, B0); PG8_BAR; PG8_SCHED;
            PG8_LDB(B1, 1, 1); PG8_STAGE(PG8_SB(1, 0), b3, voffB);
            PG8_BAR; PG8_WAIT_L(0); PG8_MMA(0, 1, At, B1); PG8_BAR;
            PG8_LDA(At, 1, 1); PG8_STAGE(PG8_SA(1, 0), a3, voffA);
            PG8_BAR; PG8_WAIT_L(0); PG8_MMA(1, 0, At, B0); PG8_BAR; PG8_SCHED;
            PG8_STAGE(PG8_SB(1, 1), b3 + hstepB, voffB);
            PG8_WAIT_V(6); PG8_BAR; PG8_MMA(1, 1, At, B1); PG8_BAR;
            }
        }
        if constexpr (ALIGN_EPI) { if (wr == 0) PG8_BAR; }
        if constexpr (!Epi::AFTER_DRAIN) { E(acc, cur, wr, wc, fr, fq); S.done(cur); }
        if (!has_next) break;
#pragma unroll
        for (int a = 0; a < 2; ++a)
#pragma unroll
            for (int b = 0; b < 2; ++b)
#pragma unroll
                for (int m = 0; m < 4; ++m)
#pragma unroll
                    for (int n = 0; n < 2; ++n) acc[a][b][m][n] = (f32x4){0.f, 0.f, 0.f, 0.f};
        cur = nxt; cA = nA; cB = nB; ++ui;
        if constexpr (ALIGN_EPI) { if (wr == 1) PG8_BAR; }
    }
    PG8_WAIT_V(0);
    if constexpr (!ALIGN_EPI) { if (wr == 0) PG8_BAR; }
    PG8_BAR;
    if constexpr (Epi::AFTER_DRAIN) { E.fused(acc, cur, wr, wc, fr, fq, lds, wid, lane); S.done(cur); }
#undef PG8_SA
#undef PG8_SB
#undef PG8_STAGE
#undef PG8_LDA
#undef PG8_LDB
#undef PG8_MMA
#undef PG8_WAIT_V
#undef PG8_WAIT_L
#undef PG8_BAR
#undef PG8_SCHED
}

}

using pg8::Unit; using pg8::Gemm;
typedef f32x4 Acc[2][2][4][2];

struct SchedBase { __device__ __forceinline__ void a_ready(const Unit&) const {} __device__ __forceinline__ void done(const Unit&) const {} };
struct SchedGrid : SchedBase { int nM, nN, G, c; long long atile, btile, acol;
    __device__ __forceinline__ bool next(int i, Unit& u) const { const int L = i * G + c; if (L >= nM * nN) return false; pg8::static_unit(L, nM, nN, u.pm, u.pn);
        u.aoff = (long long)u.pm * atile + (long long)u.pn * acol; u.boff = (long long)u.pn * btile; return true; } };
struct SchedOne : SchedBase { Unit u0; bool have;
    __device__ __forceinline__ bool next(int i, Unit& u) const { if (i != 0 || !have) return false; u = u0; return true; } };
struct SchedMoe : SchedBase { volatile LAS int* tp; int G, c; long long atile, bexp, btile;
    __device__ __forceinline__ bool next(int i, Unit& u) const { const int L = i * G + c; const int nt4 = tp[32] * 4; if (L >= nt4) return false; const int tile = L >> 2; u.pm = tile; u.pn = L & 3;
        int e = 0;
#pragma unroll 1
        for (int k = 1; k < 32; ++k) e += (tp[k] <= tile) ? 1 : 0;
        u.aoff = (long long)tile * atile; u.boff = (long long)e * bexp + (long long)u.pn * btile; return true; } };

#define EPI_COMMON static constexpr bool PERM = true, AFTER_DRAIN = false;
struct EpiIn { EPI_COMMON bf16* V; bf16* UG;
    __device__ __forceinline__ void operator()(const Acc& acc, const Unit& u, int wr, int wc, int fr, int fq) const {
        const int row0 = u.pm * 256 + wr * 64 + fr;
        if (u.pn < 4) {
#pragma unroll
            for (int ai = 0; ai < 2; ++ai)
#pragma unroll
                for (int m = 0; m < 4; ++m) { const int row = row0 + ai * 128 + m * 16;
                    const f32x4 v0 = acc[ai][0][m][0] * sig4(acc[ai][1][m][0]), v1 = acc[ai][0][m][1] * sig4(acc[ai][1][m][1]);
                    *(u32x4*)(V + (size_t)row * 512 + u.pn * 128 + wc * 32 + 8 * fq) = pack8(v0, v1); }
        } else {
#pragma unroll
            for (int ai = 0; ai < 2; ++ai)
#pragma unroll
                for (int m = 0; m < 4; ++m) { const int row = row0 + ai * 128 + m * 16; const int b = row >> 13, chunk = (row >> 5) & 255, j = row & 31;
#pragma unroll
                    for (int bj = 0; bj < 2; ++bj) { const int cu = (u.pn - 4) * 256 + bj * 128 + wc * 32 + 8 * fq; const int g = cu >> 4, c0 = cu & 15;
                        *(u32x4*)(UG + ((size_t)((g * 2 + b) * 256 + chunk)) * KY + j * 16 + c0) = pack8(acc[ai][bj][m][0], acc[ai][bj][m][1]); } }
        }
    } };
struct EpiKV { EPI_COMMON bf16* KP; bf16* VT;
    __device__ __forceinline__ void operator()(const Acc& acc, const Unit& u, int wr, int wc, int fr, int fq) const {
        const int row0 = u.pm * 256 + wr * 64 + fr;
#pragma unroll
        for (int ai = 0; ai < 2; ++ai)
#pragma unroll
            for (int m = 0; m < 4; ++m) { const int row = row0 + ai * 128 + m * 16;
#pragma unroll
                for (int bj = 0; bj < 2; ++bj) { const int col = bj * 128 + wc * 32 + 8 * fq;
                    if (u.pn < 4) *(u32x4*)(KP + (size_t)row * 1024 + u.pn * 256 + col) = pack8(acc[ai][bj][m][0], acc[ai][bj][m][1]);
                    else { const int b = row >> 8, key = row & 255, h = u.pn - 4; bf16* vt = VT + ((size_t)(b * 4 + h) * 256 + col) * 256 + key;
#pragma unroll
                        for (int n = 0; n < 2; ++n)
#pragma unroll
                            for (int e = 0; e < 4; ++e) vt[(n * 4 + e) * 256] = (bf16)f2bf(acc[ai][bj][m][n][e]); } } }
    } };
struct EpiScan { static constexpr bool PERM = true, AFTER_DRAIN = true; bf16* UG; const float* Are; const float* Aim; const float* logdt;
    __device__ __forceinline__ void fused(const Acc& acc, const Unit& u, int wr, int wc, int fr, int fq, LAS unsigned char* lds, int wid, int lane) const {
        LAS float* El = (LAS float*)lds;
#pragma unroll
        for (int ai = 0; ai < 2; ++ai)
#pragma unroll
            for (int m = 0; m < 4; ++m) { const int row = ai * 128 + wr * 64 + m * 16 + fr;
#pragma unroll
                for (int n = 0; n < 2; ++n) { const int cc = (wc * 32 + 8 * fq + 4 * n) >> 2; *(LAS f32x4*)(El + row * 128 + ((cc ^ (row & 31)) << 2)) = acc[ai][0][m][n]; } }
        __syncthreads();
        if (wid == 0) {
            const int g = u.pm >> 1, p = lane;
            const double dt = exp((double)logdt[g]); const double lr = (double)Are[g * NP + p] * dt * CH, li = (double)Aim[g * NP + p] * dt * CH;
            const double mag = exp(lr); double sn, cs; sincos(li, &sn, &cs);
            const float ar = (float)(mag * cs), aim = (float)(mag * sn);
            float sr = 0.f, si = 0.f;
            bf16* ug = UG + (size_t)u.pm * 256 * KY + KE;
#pragma unroll 4
            for (int ch = 0; ch < NCH; ++ch) {
                ug[(size_t)ch * KY + p] = (bf16)f2bf(sr); ug[(size_t)ch * KY + NP + p] = (bf16)f2bf(si);
                const int sw = ch & 31; const float er = El[ch * 128 + ((((p >> 2) ^ sw) << 2) | (p & 3))], ei = El[ch * 128 + (((((64 + p) >> 2) ^ sw) << 2) | (p & 3))];
                const float nr = ar * sr - aim * si + er, ni = ar * si + aim * sr + ei; sr = nr; si = ni;
            }
        }
    } };
struct EpiY { EPI_COMMON const bf16* UG; const float* Dv; bf16* Gb;
    __device__ __forceinline__ void operator()(const Acc& acc, const Unit& u, int wr, int wc, int fr, int fq) const {
        const int g = u.pm >> 1, b = u.pm & 1, i = u.pn * 16 + 4 * wc + fq;
        f32x4 dv[4];
#pragma unroll
        for (int k = 0; k < 4; ++k) dv[k] = *(const f32x4*)(Dv + g * 16 + 4 * k);
#pragma unroll
        for (int ai = 0; ai < 2; ++ai)
#pragma unroll
            for (int m = 0; m < 4; ++m) { const int chunk = ai * 128 + wr * 64 + m * 16 + fr;
                const u32x4* up = (const u32x4*)(UG + ((size_t)u.pm * 256 + chunk) * KY + i * 16);
                const size_t t = (size_t)b * SEQ + chunk * CH + i;
#pragma unroll
                for (int bj = 0; bj < 2; ++bj) { const u32x4 uw = up[bj]; f32x4 y0 = acc[ai][bj][m][0], y1 = acc[ai][bj][m][1];
                    y0[0] += dv[2 * bj][0] * bflo(uw.x); y0[1] += dv[2 * bj][1] * bfhi(uw.x); y0[2] += dv[2 * bj][2] * bflo(uw.y); y0[3] += dv[2 * bj][3] * bfhi(uw.y);
                    y1[0] += dv[2 * bj + 1][0] * bflo(uw.z); y1[1] += dv[2 * bj + 1][1] * bfhi(uw.z); y1[2] += dv[2 * bj + 1][2] * bflo(uw.w); y1[3] += dv[2 * bj + 1][3] * bfhi(uw.w);
#pragma unroll
                    for (int e = 0; e < 4; ++e) { y0[e] = gelu_tanh(y0[e]); y1[e] = gelu_tanh(y1[e]); }
                    *(u32x4*)(Gb + t * 512 + g * 16 + bj * 8) = pack8(y0, y1); } }
    } };
template <int MODE> struct EpiPair { EPI_COMMON bf16* O; int ld, coloff;
    __device__ __forceinline__ void operator()(const Acc& acc, const Unit& u, int wr, int wc, int fr, int fq) const {
        const int row0 = u.pm * 256 + wr * 64 + fr;
#pragma unroll
        for (int ai = 0; ai < 2; ++ai)
#pragma unroll
            for (int m = 0; m < 4; ++m) { const int row = row0 + ai * 128 + m * 16; f32x4 v0, v1;
                if (MODE == 0) { v0 = acc[ai][0][m][0] * sig4(acc[ai][1][m][0]); v1 = acc[ai][0][m][1] * sig4(acc[ai][1][m][1]); }
                else { v0 = acc[ai][0][m][0] * sig4(acc[ai][0][m][0]) * acc[ai][1][m][0]; v1 = acc[ai][0][m][1] * sig4(acc[ai][0][m][1]) * acc[ai][1][m][1]; }
                *(u32x4*)(O + (size_t)row * ld + coloff + u.pn * 128 + wc * 32 + 8 * fq) = pack8(v0, v1); }
    } };
struct EpiH1 { EPI_COMMON const float* X; float* OUT; bf16* H1B; float* RS1;
    __device__ __forceinline__ void operator()(const Acc& acc, const Unit& u, int wr, int wc, int fr, int fq) const {
        const int row0 = u.pm * 256 + wr * 64 + fr;
#pragma unroll
        for (int ai = 0; ai < 2; ++ai)
#pragma unroll
            for (int m = 0; m < 4; ++m) { const int row = row0 + ai * 128 + m * 16; float ss = 0.f;
#pragma unroll
                for (int bj = 0; bj < 2; ++bj) { const size_t o = (size_t)row * 1024 + u.pn * 256 + bj * 128 + wc * 32 + 8 * fq;
                    const f32x4 h0 = *(const f32x4*)(X + o) + acc[ai][bj][m][0], h1 = *(const f32x4*)(X + o + 4) + acc[ai][bj][m][1];
                    *(f32x4*)(OUT + o) = h0; *(f32x4*)(OUT + o + 4) = h1; *(u32x4*)(H1B + o) = pack8(h0, h1);
                    ss += (h0[0] * h0[0] + h0[1] * h0[1]) + (h0[2] * h0[2] + h0[3] * h0[3]) + (h1[0] * h1[0] + h1[1] * h1[1]) + (h1[2] * h1[2] + h1[3] * h1[3]); }
                ss += __shfl_xor(ss, 16); ss += __shfl_xor(ss, 32);
                if (fq == 0) RS1[(size_t)row * 16 + u.pn * 4 + wc] = ss; }
    } };
struct EpiQ { EPI_COMMON bf16* Q; const LAS float* rl;
    __device__ __forceinline__ void operator()(const Acc& acc, const Unit& u, int wr, int wc, int fr, int fq) const {
#pragma unroll
        for (int ai = 0; ai < 2; ++ai)
#pragma unroll
            for (int m = 0; m < 4; ++m) { const int rloc = ai * 128 + wr * 64 + m * 16 + fr; const float s = rl[rloc] * 0.0625f; const size_t row = (size_t)u.pm * 256 + rloc;
#pragma unroll
                for (int bj = 0; bj < 2; ++bj) *(u32x4*)(Q + row * 1024 + u.pn * 256 + bj * 128 + wc * 32 + 8 * fq) = pack8(acc[ai][bj][m][0] * s, acc[ai][bj][m][1] * s); }
    } };
struct EpiSm { static constexpr bool PERM = true, AFTER_DRAIN = true; bf16* P;
    __device__ __forceinline__ void fused(Acc& acc, const Unit& u, int wr, int wc, int fr, int fq, LAS unsigned char* lds, int wid, int lane) const {
        LAS float* Xm = (LAS float*)lds; LAS float* Xs = Xm + 1024;
#pragma unroll
        for (int ai = 0; ai < 2; ++ai)
#pragma unroll
            for (int m = 0; m < 4; ++m) { float v = -3.0e38f;
#pragma unroll
                for (int bj = 0; bj < 2; ++bj)
#pragma unroll
                    for (int n = 0; n < 2; ++n)
#pragma unroll
                        for (int e = 0; e < 4; ++e) v = fmaxf(v, acc[ai][bj][m][n][e]);
                v = fmaxf(v, __shfl_xor(v, 16)); v = fmaxf(v, __shfl_xor(v, 32));
                if (fq == 0) Xm[(ai * 128 + wr * 64 + m * 16 + fr) * 4 + wc] = v; }
        __syncthreads();
#pragma unroll
        for (int ai = 0; ai < 2; ++ai)
#pragma unroll
            for (int m = 0; m < 4; ++m) { const f32x4 q = *(const LAS f32x4*)(Xm + (ai * 128 + wr * 64 + m * 16 + fr) * 4); const float rm = fmaxf(fmaxf(q[0], q[1]), fmaxf(q[2], q[3])); float s = 0.f;
#pragma unroll
                for (int bj = 0; bj < 2; ++bj)
#pragma unroll
                    for (int n = 0; n < 2; ++n)
#pragma unroll
                        for (int e = 0; e < 4; ++e) { const float pe = __expf(acc[ai][bj][m][n][e] - rm); acc[ai][bj][m][n][e] = pe; s += pe; }
                s += __shfl_xor(s, 16); s += __shfl_xor(s, 32);
                if (fq == 0) Xs[(ai * 128 + wr * 64 + m * 16 + fr) * 4 + wc] = s; }
        __syncthreads();
#pragma unroll
        for (int ai = 0; ai < 2; ++ai)
#pragma unroll
            for (int m = 0; m < 4; ++m) { const int rloc = ai * 128 + wr * 64 + m * 16 + fr; const f32x4 q = *(const LAS f32x4*)(Xs + rloc * 4); const float inv = __builtin_amdgcn_rcpf((q[0] + q[1]) + (q[2] + q[3]));
                const size_t row = (size_t)u.pm * 256 + rloc;
#pragma unroll
                for (int bj = 0; bj < 2; ++bj) *(u32x4*)(P + row * 1024 + u.pn * 256 + bj * 128 + wc * 32 + 8 * fq) = pack8(acc[ai][bj][m][0] * inv, acc[ai][bj][m][1] * inv); }
    } };
struct EpiBf { EPI_COMMON bf16* O; int ld;
    __device__ __forceinline__ void operator()(const Acc& acc, const Unit& u, int wr, int wc, int fr, int fq) const {
        const int row0 = u.pm * 256 + wr * 64 + fr;
#pragma unroll
        for (int ai = 0; ai < 2; ++ai)
#pragma unroll
            for (int m = 0; m < 4; ++m) { const int row = row0 + ai * 128 + m * 16;
#pragma unroll
                for (int bj = 0; bj < 2; ++bj) *(u32x4*)(O + (size_t)row * ld + u.pn * 256 + bj * 128 + wc * 32 + 8 * fq) = pack8(acc[ai][bj][m][0], acc[ai][bj][m][1]); }
    } };
struct EpiH2 { EPI_COMMON float* OUT;
    __device__ __forceinline__ void operator()(const Acc& acc, const Unit& u, int wr, int wc, int fr, int fq) const {
        const int row0 = u.pm * 256 + wr * 64 + fr;
#pragma unroll
        for (int ai = 0; ai < 2; ++ai)
#pragma unroll
            for (int m = 0; m < 4; ++m) { const int row = row0 + ai * 128 + m * 16;
#pragma unroll
                for (int bj = 0; bj < 2; ++bj) { float* o = OUT + (size_t)row * 1024 + u.pn * 256 + bj * 128 + wc * 32 + 8 * fq;
                    const f32x4 h0 = *(const f32x4*)o + acc[ai][bj][m][0], h1 = *(const f32x4*)(o + 4) + acc[ai][bj][m][1]; *(f32x4*)o = h0; *(f32x4*)(o + 4) = h1; } }
    } };
struct EpiDown { EPI_COMMON bf16* Y; const float* gate;
    __device__ __forceinline__ void operator()(const Acc& acc, const Unit& u, int wr, int wc, int fr, int fq) const {
        const int row0 = u.pm * 256 + wr * 64 + fr;
#pragma unroll
        for (int ai = 0; ai < 2; ++ai)
#pragma unroll
            for (int m = 0; m < 4; ++m) { const int row = row0 + ai * 128 + m * 16; const float gt = gate[row];
#pragma unroll
                for (int bj = 0; bj < 2; ++bj) *(u32x4*)(Y + (size_t)row * 1024 + u.pn * 256 + bj * 128 + wc * 32 + 8 * fq) = pack8(acc[ai][bj][m][0] * gt, acc[ai][bj][m][1] * gt); }
    } };

#define XB_TMO      128
#define XB_XCNT(j)  (256  + 64 * (j))
#define XB_XSUB(j)  (1280 + 64 * (j))
#define XB_XGEN(j)  (2304 + 64 * (j))
#define XB_TOP      3328
#define XB_TOPGEN   3392
#define XCD_BAR_WORDS 3456
#define XB_SPIN_CAP (1u << 18)

__device__ __forceinline__ unsigned xb_ld(unsigned* p)              { return __hip_atomic_load(p, __ATOMIC_RELAXED, __HIP_MEMORY_SCOPE_AGENT); }
__device__ __forceinline__ unsigned xb_add(unsigned* p, unsigned v) { return __hip_atomic_fetch_add(p, v, __ATOMIC_RELAXED, __HIP_MEMORY_SCOPE_AGENT); }
__device__ __forceinline__ unsigned xb_xcc_id() { return (unsigned)__builtin_amdgcn_s_getreg((3 << 11) | 20) & 0xFu; }
#define XB_SPIN(cond, bar) do { unsigned _sp = 0; while (cond) { __builtin_amdgcn_s_sleep(1); \
    if ((++_sp & 255u) == 0u) { if (xb_ld(&(bar)[XB_TMO])) break; if (_sp > XB_SPIN_CAP) { atomicAdd(&(bar)[XB_TMO], 1u); break; } } } } while (0)

struct XcdBarrier {
    unsigned* bar; unsigned x;
    volatile LAS unsigned* st;
};

__device__ __forceinline__ XcdBarrier xcd_barrier_post(unsigned* bar, volatile LAS unsigned* st) {
    XcdBarrier b; b.bar = bar; b.x = xb_xcc_id(); b.st = st;
    if (threadIdx.x == 0) (void)xb_add(&bar[XB_XCNT(b.x)], 1u);
    return b;
}
__device__ __forceinline__ void xcd_barrier_complete(unsigned* bar, unsigned x, unsigned& nloc, unsigned& nx) {
    const unsigned G = gridDim.x * gridDim.y * gridDim.z;
    unsigned sum, cnt, mine, sp = 0u;
    for (;;) {
        sum = 0u; cnt = 0u; mine = 0u;
#pragma unroll
        for (unsigned j = 0; j < 16; ++j) { const unsigned c = xb_ld(&bar[XB_XCNT(j)]); sum += c; cnt += (c > 0u) ? 1u : 0u; mine = (j == x) ? c : mine; }
        if (sum == G) break;
        __builtin_amdgcn_s_sleep(1);
        if ((++sp & 255u) == 0u) { if (xb_ld(&bar[XB_TMO])) break; if (sp > XB_SPIN_CAP) { atomicAdd(&bar[XB_TMO], 1u); break; } }
    }
    nloc = mine > 0u ? mine : 1u; nx = cnt > 0u ? cnt : 1u;
}

__device__ __forceinline__ void xcd_barrier(const XcdBarrier& b) {
    asm volatile("s_waitcnt vmcnt(0)" ::: "memory");
    __syncthreads();
    if (threadIdx.x == 0) {
        unsigned* bar = b.bar;
        __builtin_amdgcn_s_waitcnt(0);
        unsigned nloc = b.st[0], nx = b.st[1];
        if (nloc == 0u) { xcd_barrier_complete(bar, b.x, nloc, nx); b.st[0] = nloc; b.st[1] = nx; }
        const unsigned old = xb_add(&bar[XB_XSUB(b.x)], 1u);
        const unsigned gen = old / nloc;
        if (old + 1u == (gen + 1u) * nloc) {
            __builtin_amdgcn_fence(__ATOMIC_RELEASE, "agent");
            asm volatile("s_waitcnt vmcnt(0)" ::: "memory");
            const unsigned og = xb_add(&bar[XB_TOP], 1u);
            const unsigned tg = og / nx;
            if (og + 1u == (tg + 1u) * nx) xb_add(&bar[XB_TOPGEN], 1u);
            else XB_SPIN(xb_ld(&bar[XB_TOPGEN]) == tg, bar);
            __builtin_amdgcn_fence(__ATOMIC_ACQUIRE, "agent");
            xb_add(&bar[XB_XGEN(b.x)], 1u);
            asm volatile("s_waitcnt vmcnt(0)" ::: "memory");
        } else {
            XB_SPIN(xb_ld(&bar[XB_XGEN(b.x)]) == gen, bar);
            __builtin_amdgcn_fence(__ATOMIC_ACQUIRE, "agent");
            asm volatile("s_waitcnt vmcnt(0)" ::: "memory");
        }
    }
    __syncthreads();
}

__device__ __forceinline__ void transpose_item(const float* W, int ldw, bf16* WT, int ldwt, int k0, int n0, int dst_row0, const float* kscale, LAS float* scr, int lane) {
#pragma unroll 8
    for (int i = 0; i < 32; ++i) { const int kk = 2 * i + (lane >> 5); float v = W[(size_t)(k0 + kk) * ldw + n0 + (lane & 31)]; if (kscale) v *= kscale[k0 + kk]; scr[kk * 33 + (lane & 31)] = v; }
    LDS_WAIT(); asm volatile("" ::: "memory");
    const int c = lane & 7;
#pragma unroll
    for (int j = 0; j < 4; ++j) { const int n = (lane >> 3) + 8 * j; const LAS float* s = scr + (8 * c) * 33 + n;
        u32x4 o; o.x = pk2(s[0 * 33], s[1 * 33]); o.y = pk2(s[2 * 33], s[3 * 33]); o.z = pk2(s[4 * 33], s[5 * 33]); o.w = pk2(s[6 * 33], s[7 * 33]);
        *(u32x4*)(WT + (size_t)(dst_row0 + n) * ldwt + k0 + 8 * c) = o; }
    LDS_WAIT(); asm volatile("" ::: "memory");
}
__device__ __forceinline__ void rms_row_to_bf16(const float* xrow, const float* gain, bf16* orow, int lane) {
    f32x4 v[4]; float s = 0.f;
#pragma unroll
    for (int j = 0; j < 4; ++j) { v[j] = *(const f32x4*)(xrow + (lane + 64 * j) * 4); s += (v[j][0] * v[j][0] + v[j][1] * v[j][1]) + (v[j][2] * v[j][2] + v[j][3] * v[j][3]); }
    const float r = 1.0f / sqrtf(wave_sum(s) * (1.f / D) + EPS);
#pragma unroll
    for (int j = 0; j < 4; ++j) { const f32x4 gn = *(const f32x4*)(gain + (lane + 64 * j) * 4); u32x2 o; o.x = pk2(v[j][0] * r * gn[0], v[j][1] * r * gn[1]); o.y = pk2(v[j][2] * r * gn[2], v[j][3] * r * gn[3]);
        *(u32x2*)(orow + (lane + 64 * j) * 4) = o; }
}
__device__ __forceinline__ void ssm_consts(const float* Are, const float* Aim, const float* logdt, int g, int p, double& lr, double& li, double& cr, double& ci) {
    const double dt = exp((double)logdt[g]), a = (double)Are[g * NP + p], b = (double)Aim[g * NP + p];
    lr = a * dt; li = b * dt;
    const double mag = exp(lr); double sn, cs; sincos(li, &sn, &cs);
    const double x = mag * cs - 1.0, y = mag * sn, den = a * a + b * b;
    cr = (x * a + y * b) / den; ci = (y * a - x * b) / den;
}
__device__ __forceinline__ void cpow_d(double lr, double li, int m, float& zr, float& zi) { const double mag = exp(lr * m); double sn, cs; sincos(li * m, &sn, &cs); zr = (float)(mag * cs); zi = (float)(mag * sn); }

struct Args { const float* in[33]; float* out; unsigned char* ws; int ph_lo, ph_hi; };

template <int NS> __device__ __forceinline__ void conv_block(float (&win)[CWID], const float (&w)[CWID], const bf16* vcol, float bias, LAS float* outl) {
#pragma unroll
    for (int ss = 0; ss < NS; ++ss) {
        win[ss % CWID] = bf2f(vcol[(size_t)ss * 512]);
        float a = bias;
#pragma unroll
        for (int k = 0; k < CWID; ++k) a += w[k] * win[(ss + k + 1) % CWID];
        outl[ss * 512] = a;
    }
}

__device__ __forceinline__ int toep_col(int i, int c) { return (i >> 4) * 256 + (c >> 3) * 128 + (i & 15) * 8 + (c & 7); }


#define X (args.in[0])
#define OUT (args.out)
#define WSP(T_, off) ((T_*)(ws + (off)))
#define WIN_T WSP(bf16, WS_WIN)
#define WOUT_T WSP(bf16, WS_WOUT)
#define WQ_T WSP(bf16, WS_WQ)
#define WKV_T WSP(bf16, WS_WKV)
#define WO_T WSP(bf16, WS_WO)
#define TOEP WSP(bf16, WS_TOEP)
#define ETAB WSP(bf16, WS_ETAB)
#define GLUBT WSP(bf16, WS_GLUBT)
#define MEMN WSP(bf16, WS_MEMN)
#define KPROJ WSP(bf16, WS_KPROJ)
#define VT WSP(bf16, WS_VT)
#define WUP_T WSP(bf16, WS_WUP)
#define WDN_T WSP(bf16, WS_WDN)
#define HN WSP(bf16, WS_HN)
#define VBUF WSP(bf16, WS_VBUF)
#define UG WSP(bf16, WS_UG)
#define CONCAT WSP(bf16, WS_CONCAT)
#define GB WSP(bf16, WS_G)
#define H1B WSP(bf16, WS_H1B)
#define QBUF WSP(bf16, WS_QBUF)
#define PBUF WSP(bf16, WS_PBUF)
#define OBUF WSP(bf16, WS_OBUF)
#define XG WSP(bf16, WS_XG)
#define HID WSP(bf16, WS_HID)
#define HIST WSP(int, WS_HIST)
#define TPREF WSP(int, WS_TPREF)
#define TOKE WSP(int, WS_TOKE)
#define TOKG WSP(float, WS_TOKG)
#define TOKS WSP(int, WS_TOKS)
#define RSTD3 WSP(float, WS_RSTD3)
#define SGATE WSP(float, WS_SGATE)
#define RS1 WSP(float, WS_RS1)
#define SSMC WSP(float, WS_KMAT)
__global__ void __launch_bounds__(NTHR, 2) mk_fwd(Args args) {
    extern __shared__ __attribute__((aligned(16))) unsigned char lds_raw[];
    LAS unsigned char* lds = (LAS unsigned char*)lds_raw;
    const int tid = threadIdx.x, lane = tid & 63, wave = __builtin_amdgcn_readfirstlane(tid >> 6);
    const int G = gridDim.x, c = blockIdx.x;
    const int vcu = (G % 8 == 0) ? (c % 8) * (G / 8) + c / 8 : c;
    const int gw = vcu * NWAVES + wave, NGW = G * NWAVES;
    unsigned char* ws = args.ws;
    volatile LAS unsigned* LCTL = (volatile LAS unsigned*)(lds + LCTL_OFF);
    for (int u = tid; u < 128; u += NTHR) LCTL[u] = 0u;
    __syncthreads();
    XcdBarrier bar; bar.bar = (unsigned*)(ws + WS_CTL) + CW_BAR; bar.x = 0; bar.st = nullptr;
    if (!MK_PER_PHASE) bar = xcd_barrier_post((unsigned*)(ws + WS_CTL) + CW_BAR, LCTL + 8);
#define GRID_BAR() do { if (!MK_PER_PHASE) xcd_barrier(bar); } while (0)
    const int lo = args.ph_lo, hi = args.ph_hi;
#ifndef PH_MASK
#define PH_MASK 0x1fff
#endif
#define IN(k) (((PH_MASK >> (k)) & 1) && lo <= (k) && (k) < hi)
#define BOTH(k) (IN(k) && IN((k) + 1))

    if (IN(0)) {
        const int gt = gw * 64 + lane, NGT = NGW * 64;
        for (int idx = gt; idx < NG * NP; idx += NGT) { const int g = idx >> 6, p = idx & 63; double lr, li, cr, ci; ssm_consts(args.in[8], args.in[9], args.in[10], g, p, lr, li, cr, ci);
            float ar, ai; cpow_d(lr, li, 1, ar, ai); float* o = SSMC + (size_t)idx * 8; o[0] = (float)lr; o[1] = (float)li; o[2] = (float)cr; o[3] = (float)ci; o[4] = ar; o[5] = ai; o[6] = 0.f; o[7] = 0.f; }
        for (int idx = gt; idx < 4 * 256 * 128; idx += NGT) { const int pn = idx >> 15, np = (idx >> 7) & 255, k = idx & 127; const int bj = np >> 7, gl = (np >> 4) & 7, e = np & 15; const int g = pn * 8 + gl;
            const float v = ((k >> 4) == gl) ? args.in[16][(size_t)(g * 16 + (k & 15)) * 32 + bj * 16 + e] : 0.f; GLUBT[idx] = (bf16)f2bf(v); }
        for (int m = gw; m < T; m += NGW) rms_row_to_bf16(X + (size_t)m * D, args.in[2], HN + (size_t)m * D, lane);
        for (int m = gw; m < TM; m += NGW) rms_row_to_bf16(args.in[1] + (size_t)m * D, args.in[19], MEMN + (size_t)m * D, lane);
        LAS float* scr = (LAS float*)(lds + wave * 16384);
        constexpr int I_IN = 16 * 48, I_SQ = 16 * 32, I_E = 768, NITEMS = I_IN + 5 * I_SQ + NE * I_E;
        for (int it = gw; it < NITEMS; it += NGW) {
            int r = it;
            if (r < I_IN) { const int kb = r / 48, nb = r % 48, n0 = nb * 32; const int dst = (n0 < 1024) ? (((n0 & 511) >> 7) * 256 + (n0 >> 9) * 128 + (n0 & 127)) : n0;
                transpose_item(args.in[3], 1536, WIN_T, 1024, kb * 64, n0, dst, nullptr, scr, lane); continue; } r -= I_IN;
            if (r < 5 * I_SQ) { const int w = r / I_SQ, q = r % I_SQ, kb = q / 32, n0 = (q % 32) * 32;
                const float* src = (w == 0) ? args.in[17] : (w == 1) ? args.in[20] : (w == 2) ? args.in[21] : (w == 3) ? args.in[22] : args.in[23];
                bf16* dstp = (w == 0) ? WOUT_T : (w == 1) ? WQ_T : (w == 2) ? WKV_T : (w == 3) ? WKV_T + (size_t)1024 * 1024 : WO_T;
                transpose_item(src, 1024, dstp, 1024, kb * 64, n0, n0, (w == 1) ? args.in[18] : nullptr, scr, lane); continue; } r -= 5 * I_SQ;
            { const int e = r / I_E, q = r % I_E;
              if (q < 512) { const int which = q >> 8, qq = q & 255, kb = qq >> 4, n0 = (qq & 15) * 32;
                  transpose_item((which ? args.in[30] : args.in[29]) + (size_t)e * 1024 * 512, 512, WUP_T + (size_t)e * 1024 * 1024, 1024, kb * 64, n0, (n0 >> 7) * 256 + which * 128 + (n0 & 127), nullptr, scr, lane); }
              else { const int qq = q - 512, kb = qq >> 5, n0 = (qq & 31) * 32;
                  transpose_item(args.in[31] + (size_t)e * 512 * 1024, 1024, WDN_T + (size_t)e * 1024 * 512, 512, kb * 64, n0, n0, nullptr, scr, lane); } }
        }
        if (BOTH(0)) GRID_BAR();
    }

    if (IN(1)) {
        { Gemm g{HN, WIN_T, 1024, 1024, 1024}; SchedGrid S; S.nM = 64; S.nN = 6; S.G = G; S.c = c; S.atile = 256ll * 1024 * 2; S.btile = 256ll * 1024 * 2; S.acol = 0;
          EpiIn E{VBUF, UG}; pg8::gemm_phase<EpiIn, SchedGrid, true, true>(lds, g, S, E); }
        if (c >= 128) {
            if (c < 144) { Gemm g{MEMN, WKV_T, 1024, 1024, 1024}; SchedOne S; const int L = c - 128; S.have = true; S.u0.pm = L >> 3; S.u0.pn = L & 7; S.u0.aoff = (long long)(L >> 3) * 256 * 1024 * 2; S.u0.boff = (long long)(L & 7) * 256 * 1024 * 2;
                EpiKV E{KPROJ, VT}; pg8::gemm_phase<EpiKV, SchedOne, true, true>(lds, g, S, E); }
            const int sidx = (c - 128) * NTHR + tid, NS = 128 * NTHR;
            const float* Bre = args.in[11]; const float* Bim = args.in[12]; const float* Cre = args.in[13]; const float* Cim = args.in[14];
            for (int idx = sidx; idx < NG * 128 * CH; idx += NS) { const int g = idx >> 12, q = (idx >> 5) & 127, j = idx & 31, p = q & 63; const float* sc = SSMC + (size_t)(g * NP + p) * 8;
                const float m = (float)(CH - 1 - j); const float mag = expf(sc[0] * m); float sn, cs; sincosf(sc[1] * m, &sn, &cs);
                const float pr = mag * cs, pi = mag * sn, zr = pr * sc[2] - pi * sc[3], zi = pr * sc[3] + pi * sc[2];
                f32x4 o[4];
#pragma unroll
                for (int k = 0; k < 4; ++k) { const f32x4 br = *(const f32x4*)(Bre + (size_t)(g * NP + p) * 16 + 4 * k), bi = *(const f32x4*)(Bim + (size_t)(g * NP + p) * 16 + 4 * k);
                    o[k] = (q < 64) ? (br * zr - bi * zi) : (bi * zr + br * zi); }
                bf16* d = ETAB + (size_t)(g * 128 + q) * KE + j * 16; *(u32x4*)d = pack8(o[0], o[1]); *(u32x4*)(d + 8) = pack8(o[2], o[3]); }
            for (int idx = sidx; idx < NG * 512 * NP; idx += NS) { const int g = idx >> 15, n = (idx >> 6) & 511, p = idx & 63; const int i = (n >> 8) * 16 + ((n >> 3) & 15), cch = ((n >> 7) & 1) * 8 + (n & 7);
                const float* sc = SSMC + (size_t)(g * NP + p) * 8; const float m = (float)(i + 1); const float mag = expf(sc[0] * m); float sn, cs; sincosf(sc[1] * m, &sn, &cs);
                const float pr = mag * cs, pi = mag * sn, cr = Cre[(size_t)(g * 16 + cch) * NP + p], ci = Cim[(size_t)(g * 16 + cch) * NP + p];
                bf16* d = TOEP + (size_t)(g * 512 + n) * KY + KE; d[p] = (bf16)f2bf(cr * pr - ci * pi); d[NP + p] = (bf16)f2bf(-(cr * pi + ci * pr)); }
            for (int idx = sidx; idx < NG * 256 * 4; idx += NS) { const int pq = idx & 3, cc = (idx >> 2) & 255, g = idx >> 10, c1 = cc >> 4, c2 = cc & 15;
                float ks[CH];
#pragma unroll
                for (int l = 0; l < CH; ++l) ks[l] = 0.f;
                for (int pp = 0; pp < 16; ++pp) { const int p = pq * 16 + pp; const float* sc = SSMC + (size_t)(g * NP + p) * 8;
                    const float br = Bre[(size_t)(g * NP + p) * 16 + c2], bi = Bim[(size_t)(g * NP + p) * 16 + c2], bbr = sc[2] * br - sc[3] * bi, bbi = sc[2] * bi + sc[3] * br;
                    const float cr = Cre[(size_t)(g * 16 + c1) * NP + p], ci = Cim[(size_t)(g * 16 + c1) * NP + p]; float zr = cr * bbr - ci * bbi, zi = cr * bbi + ci * bbr; const float ar = sc[4], ai = sc[5];
#pragma unroll
                    for (int l = 0; l < CH; ++l) { ks[l] += zr; const float t = zr * ar - zi * ai; zi = zr * ai + zi * ar; zr = t; } }
#pragma unroll
                for (int l = 0; l < CH; ++l) { ks[l] += __shfl_xor(ks[l], 1); ks[l] += __shfl_xor(ks[l], 2); }
#pragma unroll
                for (int l = 0; l < CH; ++l) if ((l & 3) == pq) { const bf16 v = (bf16)f2bf(ks[l]);
                    for (int i = l; i < CH; ++i) TOEP[(size_t)(g * 512 + toep_col(i, c1)) * KY + (i - l) * 16 + c2] = v; } }
            for (int idx = sidx; idx < NG * 512 * CH; idx += NS) { const int g = idx >> 14, n = (idx >> 5) & 511, j = idx & 31; const int i = (n >> 8) * 16 + ((n >> 3) & 15);
                if (j > i) { bf16* d = TOEP + (size_t)(g * 512 + n) * KY + j * 16; const u32x4 z = {0u, 0u, 0u, 0u}; *(u32x4*)d = z; *(u32x4*)(d + 8) = z; } }
        }
        if (BOTH(1)) GRID_BAR();
    }

    if (IN(2)) {
        if (c < 64) { Gemm g{UG, ETAB, KY, KE, KE}; SchedOne S; S.have = true; S.u0.pm = c; S.u0.pn = 0; S.u0.aoff = (long long)c * 256 * KY * 2; S.u0.boff = (long long)(c >> 1) * 128 * KE * 2;
            EpiScan E{UG, args.in[8], args.in[9], args.in[10]}; pg8::gemm_phase<EpiScan, SchedOne, false, true>(lds, g, S, E); }
        else {
            const int ch = tid; float w[CWID];
#pragma unroll
            for (int k = 0; k < CWID; ++k) w[k] = args.in[4][k * DCONV + ch];
            const float bias = args.in[5][ch];
            LAS float* outl = (LAS float*)lds;
            for (int tile = c - 64; tile < T / 64; tile += G - 64) {
                const int t0 = tile * 64, tb0 = (t0 >> 13) << 13; float win[CWID];
                win[0] = 0.f;
#pragma unroll
                for (int i = 0; i < CWID - 1; ++i) { const int tt = t0 - (CWID - 1) + i; win[i + 1] = (tt >= tb0) ? bf2f(VBUF[(size_t)tt * 512 + ch]) : 0.f; }
                conv_block<31>(win, w, VBUF + (size_t)t0 * 512 + ch, bias, outl + ch);
                conv_block<31>(win, w, VBUF + (size_t)(t0 + 31) * 512 + ch, bias, outl + 31 * 512 + ch);
                conv_block<2>(win, w, VBUF + (size_t)(t0 + 62) * 512 + ch, bias, outl + 62 * 512 + ch);
                __syncthreads();
                for (int r = 0; r < 8; ++r) { const int tok = wave * 8 + r; float v[8]; float s = 0.f;
#pragma unroll
                    for (int j = 0; j < 8; ++j) { v[j] = outl[tok * 512 + lane + 64 * j]; s += v[j]; }
                    const float mean = wave_sum(s) * (1.f / 512.f); float q = 0.f;
#pragma unroll
                    for (int j = 0; j < 8; ++j) { v[j] -= mean; q += v[j] * v[j]; }
                    const float rstd = 1.0f / sqrtf(wave_sum(q) * (1.f / 512.f) + EPS);
#pragma unroll
                    for (int j = 0; j < 8; ++j) { const int cch = lane + 64 * j; const float o = v[j] * rstd * args.in[6][cch] + args.in[7][cch]; CONCAT[(size_t)(t0 + tok) * 1024 + cch] = (bf16)f2bf(o * sigmoidf_(o)); } }
                __syncthreads();
            }
        }
        if (BOTH(2)) GRID_BAR();
    }

    if (IN(3)) {
        if (c < 128) { const int g = c >> 2, b = (c >> 1) & 1, pn = c & 1; Gemm gm{UG, TOEP, KY, KY, KY}; SchedOne S; S.have = true; S.u0.pm = g * 2 + b; S.u0.pn = pn;
            S.u0.aoff = (long long)(g * 2 + b) * 256 * KY * 2; S.u0.boff = (long long)(g * 512 + pn * 256) * KY * 2;
            EpiY E{UG, args.in[15], GB}; pg8::gemm_phase<EpiY, SchedOne, true, true>(lds, gm, S, E); }
        if (BOTH(3)) GRID_BAR();
    }

    if (IN(4)) {
        { Gemm g{GB, GLUBT, 512, 128, 128}; SchedGrid S; S.nM = 64; S.nN = 4; S.G = G; S.c = c; S.atile = 256ll * 512 * 2; S.btile = 256ll * 128 * 2; S.acol = 128 * 2;
          EpiPair<0> E{CONCAT, 1024, 512}; pg8::gemm_phase<EpiPair<0>, SchedGrid, true, true>(lds, g, S, E); }
        if (BOTH(4)) GRID_BAR();
    }

    if (IN(5)) {
        { Gemm g{CONCAT, WOUT_T, 1024, 1024, 1024}; SchedGrid S; S.nM = 64; S.nN = 4; S.G = G; S.c = c; S.atile = 256ll * 1024 * 2; S.btile = 256ll * 1024 * 2; S.acol = 0;
          EpiH1 E{X, OUT, H1B, RS1}; pg8::gemm_phase<EpiH1, SchedGrid, true, true>(lds, g, S, E); }
        if (BOTH(5)) GRID_BAR();
    }

    if (IN(6)) {
        if (c < 256) {
            int pm, pn; pg8::static_unit(c, 64, 4, pm, pn); const int b = pm >> 5, h = pn;
            LAS float* rl = (LAS float*)(lds + EXT_OFF);
            for (int r = tid; r < 256; r += NTHR) { const float* p = RS1 + ((size_t)pm * 256 + r) * 16; float s = 0.f;
#pragma unroll
                for (int j = 0; j < 4; ++j) { const f32x4 v = *(const f32x4*)(p + 4 * j); s += (v[0] + v[1]) + (v[2] + v[3]); }
                rl[r] = 1.0f / sqrtf(s * (1.f / D) + EPS); }
            __syncthreads();
            SchedOne S; S.have = true; S.u0.pm = pm; S.u0.pn = pn;
            { Gemm g{H1B, WQ_T, 1024, 1024, 1024}; S.u0.aoff = (long long)pm * 256 * 1024 * 2; S.u0.boff = (long long)pn * 256 * 1024 * 2;
              EpiQ E{QBUF, rl}; pg8::gemm_phase<EpiQ, SchedOne, true, true>(lds, g, S, E); }
            VM_WAIT(); __syncthreads();
            { Gemm g{QBUF, KPROJ, 1024, 1024, 256}; S.u0.aoff = ((long long)pm * 256 * 1024 + h * 256) * 2; S.u0.boff = ((long long)b * 256 * 1024 + h * 256) * 2;
              EpiSm E{PBUF}; pg8::gemm_phase<EpiSm, SchedOne, false, true>(lds, g, S, E); }
            VM_WAIT(); __syncthreads();
            { Gemm g{PBUF, VT, 1024, 256, 256}; S.u0.aoff = ((long long)pm * 256 * 1024 + h * 256) * 2; S.u0.boff = (long long)(b * 4 + h) * 65536 * 2;
              EpiBf E{OBUF, 1024}; pg8::gemm_phase<EpiBf, SchedOne, true, true>(lds, g, S, E); }
        }
        if (BOTH(6)) GRID_BAR();
    }

    if (IN(7)) {
        { Gemm g{OBUF, WO_T, 1024, 1024, 1024}; SchedGrid S; S.nM = 64; S.nN = 4; S.G = G; S.c = c; S.atile = 256ll * 1024 * 2; S.btile = 256ll * 1024 * 2; S.acol = 0;
          EpiH2 E{OUT}; pg8::gemm_phase<EpiH2, SchedGrid, true, true>(lds, g, S, E); }
        if (BOTH(7)) GRID_BAR();
    }

    if (IN(8)) {
        for (int blk = c; blk < T / 64; blk += G) {
            const int t0 = blk * 64;
            LAS float* Xs = (LAS float*)lds;
            float av[NCOLR + 1];
#pragma unroll
            for (int k = 0; k <= NCOLR; ++k) av[k] = 0.f;
            const CAS float* wg4 = (const CAS float*)(unsigned long long)args.in[25]; const CAS float* we4 = (const CAS float*)(unsigned long long)args.in[27]; const CAS float* wf4 = (const CAS float*)(unsigned long long)args.in[24];
            for (int kh = 0; kh < 2; ++kh) {
                for (int it = 0; it < 16; ++it) { const int idx = it * NTHR + tid, tok = idx >> 7, kq = (idx & 127) * 4; const f32x4 v = *(const f32x4*)(OUT + (size_t)(t0 + tok) * 1024 + kh * 512 + kq);
                    LAS float* d = Xs + tok * 513 + kq; d[0] = v[0]; d[1] = v[1]; d[2] = v[2]; d[3] = v[3]; }
                __syncthreads();
                const int kbase = kh * 512 + wave * 64;
#pragma unroll 1
                for (int kk = 0; kk < 64; ++kk) { const int k = kbase + kk; const float x = Xs[lane * 513 + wave * 64 + kk]; av[NCOLR] += x * x; const float xw = x * wf4[k];
#pragma unroll
                    for (int q = 0; q < 4; ++q) av[q] += xw * wg4[k * 4 + q];
#pragma unroll
                    for (int q = 0; q < 32; ++q) av[4 + q] += xw * we4[k * 32 + q]; }
                __syncthreads();
            }
            LAS float* Part = (LAS float*)lds;
#pragma unroll
            for (int q = 0; q <= NCOLR; ++q) Part[(wave * (NCOLR + 1) + q) * 64 + lane] = av[q];
            LAS float* Lg = (LAS float*)(lds + EXT_OFF + 1024);
            LAS int* lh = (LAS int*)(lds + EXT_OFF + 1024 + 64 * 40 * 4);
            if (tid < 32) lh[tid] = 0;
            __syncthreads();
            for (int idx = tid; idx < 64 * (NCOLR + 1); idx += NTHR) { const int tok = idx & 63, q = idx >> 6; float s = 0.f;
#pragma unroll
                for (int w8 = 0; w8 < 8; ++w8) s += Part[(w8 * (NCOLR + 1) + q) * 64 + tok];
                Lg[tok * 40 + q] = s; }
            __syncthreads();
            if (tid < 64) { const int t = t0 + tid; const LAS float* L = Lg + tid * 40; const float rstd = 1.0f / sqrtf(L[NCOLR] * (1.f / D) + EPS); RSTD3[t] = rstd;
                float gl[4]; int gi = 0; float gm;
#pragma unroll
                for (int q = 0; q < 4; ++q) gl[q] = L[q] * rstd + args.in[26][q];
                gm = gl[0];
#pragma unroll
                for (int q = 1; q < 4; ++q) if (gl[q] > gm) { gm = gl[q]; gi = q; }
                float gs = 0.f;
#pragma unroll
                for (int q = 0; q < 4; ++q) gs += expf(gl[q] - gm);
                const float gwt = 1.0f / gs;
                float el[8];
#pragma unroll
                for (int q = 0; q < 8; ++q) el[q] = L[4 + gi * 8 + q] * rstd + args.in[28][gi * 8 + q];
                int i1 = 0; float l1 = el[0];
#pragma unroll
                for (int q = 1; q < 8; ++q) if (el[q] > l1) { l1 = el[q]; i1 = q; }
                int i2 = -1; float l2 = -3.0e38f;
#pragma unroll
                for (int q = 0; q < 8; ++q) if (q != i1 && el[q] > l2) { l2 = el[q]; i2 = q; }
                const float p2 = 1.0f / (1.0f + expf(l1 - l2)), p1 = 1.0f - p2;
                const int e1 = gi * 8 + i1, e2 = gi * 8 + i2;
                TOKE[t * 2] = e1; TOKE[t * 2 + 1] = e2; TOKG[t * 2] = gwt * p1; TOKG[t * 2 + 1] = gwt * p2;
                atomicAdd((int*)&lh[e1], 1); atomicAdd((int*)&lh[e2], 1); }
            __syncthreads();
            if (tid < 32) HIST[blk * 32 + tid] = lh[tid];
            __syncthreads();
        }
        if (BOTH(8)) GRID_BAR();
    }

    if (IN(9)) {
        for (int blk = c; blk < T / 64; blk += G) {
            const int t0 = blk * 64;
            LAS int* li = (LAS int*)lds; LAS int* cnt = li; LAS int* wgoff = li + 32; LAS int* base = li + 64; LAS int* lcnt = li + 96; LAS int* tpl = li + 128; LAS int* sl = li + 192;
            if (tid < 32) { int total = 0, off = 0; for (int w8 = 0; w8 < T / 64; ++w8) { const int hv = HIST[w8 * 32 + tid]; total += hv; off += (w8 < blk) ? hv : 0; } cnt[tid] = total; wgoff[tid] = off; lcnt[tid] = 0; }
            __syncthreads();
            if (tid == 0) { int a = 0; for (int e = 0; e < 32; ++e) { tpl[e] = a; base[e] = a * 256; a += (cnt[e] + 255) >> 8; } tpl[32] = a; }
            __syncthreads();
            if (blk == 0 && tid < 33) TPREF[tid] = tpl[tid];
            if (tid < 128) { const int tok = t0 + (tid >> 1), k = tid & 1; const int e = TOKE[tok * 2 + k]; const int rank = atomicAdd((int*)&lcnt[e], 1); const int slot = base[e] + wgoff[e] + rank;
                TOKS[tok * 2 + k] = slot; SGATE[slot] = TOKG[tok * 2 + k]; sl[tid] = slot; }
            __syncthreads();
            for (int r = 0; r < 8; ++r) { const int tl = wave * 8 + r, tok = t0 + tl; const int s0 = sl[tl * 2], s1 = sl[tl * 2 + 1]; const float rstd = RSTD3[tok];
#pragma unroll
                for (int j = 0; j < 4; ++j) { const int col = (lane + 64 * j) * 4; const f32x4 v = *(const f32x4*)(OUT + (size_t)tok * 1024 + col), gn = *(const f32x4*)(args.in[24] + col);
                    u32x2 o; o.x = pk2(v[0] * rstd * gn[0], v[1] * rstd * gn[1]); o.y = pk2(v[2] * rstd * gn[2], v[3] * rstd * gn[3]);
                    *(u32x2*)(XG + (size_t)s0 * 1024 + col) = o; *(u32x2*)(XG + (size_t)s1 * 1024 + col) = o; } }
            __syncthreads();
        }
        if (BOTH(9)) GRID_BAR();
    }

    if (IN(10)) {
        volatile LAS int* tp = (volatile LAS int*)(lds + EXT_OFF + 8192);
        if (tid < 33) tp[tid] = TPREF[tid];
        __syncthreads();
        { Gemm g{XG, WUP_T, 1024, 1024, 1024}; SchedMoe S; S.tp = tp; S.G = G; S.c = c; S.atile = 256ll * 1024 * 2; S.bexp = 1024ll * 1024 * 2; S.btile = 256ll * 1024 * 2;
          EpiPair<1> E{HID, 512, 0}; pg8::gemm_phase<EpiPair<1>, SchedMoe, true, true>(lds, g, S, E); }
        if (BOTH(10)) GRID_BAR();
    }

    if (IN(11)) {
        volatile LAS int* tp = (volatile LAS int*)(lds + EXT_OFF + 8192);
        if (tid < 33) tp[tid] = TPREF[tid];
        __syncthreads();
        { Gemm g{HID, WDN_T, 512, 512, 512}; SchedMoe S; S.tp = tp; S.G = G; S.c = c; S.atile = 256ll * 512 * 2; S.bexp = 1024ll * 512 * 2; S.btile = 256ll * 512 * 2;
          EpiDown E{XG, SGATE}; pg8::gemm_phase<EpiDown, SchedMoe, true, true>(lds, g, S, E); }
        if (BOTH(11)) GRID_BAR();
    }

    if (IN(12)) {
        for (int tok = gw; tok < T; tok += NGW) { const int s0 = TOKS[tok * 2], s1 = TOKS[tok * 2 + 1]; f32x4 v[4]; float ss = 0.f;
#pragma unroll
            for (int j = 0; j < 4; ++j) { const int col = (lane + 64 * j) * 4; v[j] = *(const f32x4*)(OUT + (size_t)tok * 1024 + col);
                const u32x2 a = *(const u32x2*)(XG + (size_t)s0 * 1024 + col), b2 = *(const u32x2*)(XG + (size_t)s1 * 1024 + col);
                v[j][0] += bflo(a.x) + bflo(b2.x); v[j][1] += bfhi(a.x) + bfhi(b2.x); v[j][2] += bflo(a.y) + bflo(b2.y); v[j][3] += bfhi(a.y) + bfhi(b2.y);
                ss += (v[j][0] * v[j][0] + v[j][1] * v[j][1]) + (v[j][2] * v[j][2] + v[j][3] * v[j][3]); }
            const float r = 1.0f / sqrtf(wave_sum(ss) * (1.f / D) + EPS);
#pragma unroll
            for (int j = 0; j < 4; ++j) { const int col = (lane + 64 * j) * 4; const f32x4 gn = *(const f32x4*)(args.in[32] + col); *(f32x4*)(OUT + (size_t)tok * 1024 + col) = v[j] * r * gn; } }
    }
#undef IN
#undef BOTH
#undef GRID_BAR
}

extern "C" void kernel_launch(void* const* d_in, const int* in_sizes, int n_in, void* d_out, int out_size, void* d_ws, size_t ws_size, hipStream_t stream) {
    static int grid = 0;
    if (grid == 0) {
        if (n_in != 33 || in_sizes[0] != T * D || out_size != T * D || ws_size < WS_END) { fprintf(stderr, "kernel_launch: unexpected shapes (n_in %d, in0 %d, out %d, ws %zu); nothing launched\n", n_in, n_in > 0 ? in_sizes[0] : -1, out_size, ws_size); grid = -1; return; }
        int dev = 0, cus = 0, per_cu = 0;
        if (hipGetDevice(&dev) != hipSuccess || hipDeviceGetAttribute(&cus, hipDeviceAttributeMultiprocessorCount, dev) != hipSuccess) { grid = -1; return; }
        if (hipFuncSetAttribute((const void*)mk_fwd, hipFuncAttributeMaxDynamicSharedMemorySize, LDS_BYTES) != hipSuccess) { fprintf(stderr, "kernel_launch: hipFuncSetAttribute failed\n"); grid = -1; return; }
        if (hipOccupancyMaxActiveBlocksPerMultiprocessor(&per_cu, (const void*)mk_fwd, NTHR, LDS_BYTES) != hipSuccess || per_cu < 1) fprintf(stderr, "kernel_launch: note: occupancy query reports %d\n", per_cu);
        (void)hipGetLastError();
        grid = cus;
        if (grid != 256) { fprintf(stderr, "kernel_launch: built for a 256-CU device, got %d CUs; nothing launched\n", grid); grid = -1; return; }
    }
    if (grid < 0) return;
    if (hipMemsetAsync((char*)d_ws + WS_CTL, 0, CTL_ZERO_BYTES, stream) != hipSuccess) return;
    Args a{};
    for (int i = 0; i < 33; ++i) a.in[i] = (const float*)d_in[i];
    a.out = (float*)d_out; a.ws = (unsigned char*)d_ws;
#if MK_PER_PHASE
    for (int ph = 0; ph < NPHASE; ++ph) { a.ph_lo = ph; a.ph_hi = ph + 1; hipLaunchKernelGGL(mk_fwd, dim3(grid), dim3(NTHR), LDS_BYTES, stream, a); }
#else
    a.ph_lo = 0; a.ph_hi = NPHASE; hipLaunchKernelGGL(mk_fwd, dim3(grid), dim3(NTHR), LDS_BYTES, stream, a);
#endif
}
```

```cpp
#include <hip/hip_runtime.h>
#include <cstdio>
#include <cstdint>

#define LAS __attribute__((address_space(3)))
#define GAS __attribute__((address_space(1)))
#define CAS __attribute__((address_space(4)))
typedef unsigned short bf16;
typedef short bf16x8 __attribute__((ext_vector_type(8)));
typedef float f32x4 __attribute__((ext_vector_type(4)));
typedef float f32x2 __attribute__((ext_vector_type(2)));
typedef unsigned u32x4 __attribute__((ext_vector_type(4)));
typedef unsigned u32x2 __attribute__((ext_vector_type(2)));

#ifndef MK_PER_PHASE
#define MK_PER_PHASE 0
#endif

constexpr int NB = 2, SEQ = 8192, D = 1024, T = NB * SEQ, MEML = 256, TM = NB * MEML;
constexpr int DCONV = 512, CWID = 31, NG = 32, SGC = 16, NP = 64, NH = 4, HD = 256, NE = 32, EPG = 8, NGRP = 4, DE = 512;
constexpr int CH = 32, NCH = SEQ / CH, KE = CH * SGC, KY = KE + 2 * NP;
constexpr int CAP = 40960;
constexpr int NCOLR = 36;
constexpr float EPS = 1e-6f;
constexpr int NWAVES = 8, NTHR = 512, NPHASE = 13;

constexpr size_t MiB = 1u << 20, KiB = 1024;
constexpr size_t WS_CTL = 0, CTL_ZERO_BYTES = 32 * KiB;
constexpr int CW_BAR = 1024;
constexpr size_t WS_HIST = 1 * MiB, WS_TPREF = WS_HIST + 32 * KiB, WS_TOKE = WS_HIST + 64 * KiB, WS_TOKG = WS_HIST + 192 * KiB, WS_TOKS = WS_HIST + 320 * KiB,
                 WS_RSTD3 = WS_HIST + 448 * KiB, WS_SGATE = WS_HIST + 512 * KiB, WS_W36 = WS_HIST + 768 * KiB;
constexpr size_t WS_RS1 = 2 * MiB, WS_KMAT = 3 * MiB;
constexpr size_t WS_WIN = 8 * MiB, WS_WOUT = 11 * MiB, WS_WQ = 13 * MiB, WS_WKV = 15 * MiB, WS_WO = 19 * MiB, WS_TOEP = 21 * MiB, WS_ETAB = 41 * MiB, WS_GLUBT = 46 * MiB,
                 WS_MEMN = 47 * MiB, WS_KPROJ = 48 * MiB, WS_VT = 49 * MiB;
constexpr size_t WS_WUP = 50 * MiB, WS_WDN = 114 * MiB;
constexpr size_t WS_ACT = 146 * MiB;
constexpr size_t WS_HN = WS_ACT, WS_VBUF = WS_ACT + 32 * MiB, WS_UG = WS_ACT + 48 * MiB, WS_CONCAT = WS_ACT + 68 * MiB, WS_G = WS_ACT + 100 * MiB;
constexpr size_t WS_H1B = WS_ACT, WS_QBUF = WS_ACT + 32 * MiB, WS_PBUF = WS_ACT + 68 * MiB, WS_OBUF = WS_ACT + 100 * MiB;
constexpr size_t WS_XG = WS_ACT, WS_HID = WS_ACT + 80 * MiB;
constexpr size_t WS_END = 280 * MiB;
static_assert(WS_G + (size_t)T * 512 * 2 <= WS_END && WS_OBUF + (size_t)T * D * 2 <= WS_END && WS_HID + (size_t)CAP * DE * 2 <= WS_END && WS_UG + (size_t)NG * NB * NCH * KY * 2 <= WS_CONCAT, "d_ws map");

constexpr int RING_BYTES = 131072, EXT_OFF = RING_BYTES, EXT_BYTES = 16384, LCTL_OFF = EXT_OFF + EXT_BYTES, LDS_BYTES = LCTL_OFF + 512;

#define LDS_WAIT() asm volatile("s_waitcnt lgkmcnt(0)" ::: "memory")
#define VM_WAIT() asm volatile("s_waitcnt vmcnt(0)" ::: "memory")
__device__ __forceinline__ unsigned f2bf(float f) { unsigned u = __builtin_bit_cast(unsigned, f); return (u + 0x7fffu + ((u >> 16) & 1u)) >> 16; }
__device__ __forceinline__ unsigned pk2(float lo, float hi) { return f2bf(lo) | (f2bf(hi) << 16); }
__device__ __forceinline__ float bf2f(unsigned h) { return __builtin_bit_cast(float, h << 16); }
__device__ __forceinline__ float bflo(unsigned w) { return __builtin_bit_cast(float, w << 16); }
__device__ __forceinline__ float bfhi(unsigned w) { return __builtin_bit_cast(float, w & 0xffff0000u); }
__device__ __forceinline__ unsigned cvt_pk_bf16(float lo, float hi) { unsigned r; asm volatile("v_cvt_pk_bf16_f32 %0, %1, %2" : "=v"(r) : "v"(lo), "v"(hi)); return r; }
__device__ __forceinline__ u32x4 pack8(const f32x4 a, const f32x4 b) { u32x4 w; w.x = cvt_pk_bf16(a[0], a[1]); w.y = cvt_pk_bf16(a[2], a[3]); w.z = cvt_pk_bf16(b[0], b[1]); w.w = cvt_pk_bf16(b[2], b[3]); return w; }
__device__ __forceinline__ float sigmoidf_(float x) { return __builtin_amdgcn_rcpf(1.0f + __expf(-x)); }
__device__ __forceinline__ f32x4 sig4(f32x4 x) { f32x4 r; r[0] = sigmoidf_(x[0]); r[1] = sigmoidf_(x[1]); r[2] = sigmoidf_(x[2]); r[3] = sigmoidf_(x[3]); return r; }
__device__ __forceinline__ float gelu_tanh(float x) { const float z = 0.7978845608028654f * (x + 0.044715f * x * x * x); const float th = 1.0f - 2.0f * __builtin_amdgcn_rcpf(1.0f + __expf(2.0f * z)); return 0.5f * x * (1.0f + th); }
__device__ __forceinline__ float wave_sum(float v) {
#pragma unroll
    for (int o = 1; o < 64; o <<= 1) v += __shfl_xor(v, o);
    return v;
}

namespace pg8 {
#define PG8_LAS __attribute__((address_space(3)))
typedef unsigned short bf16_t;
constexpr int BM = 256, BK = 64, HALF = 128, HTB = HALF * BK * 2  , STAGE_BYTES = 8 * HTB, NXCD = 8, WGM = 8;
__host__ __device__ __forceinline__ int lds_byte(int r, int c) { const int st = (r >> 4) * 2 + (c >> 5), rr = r & 15, cc = c & 31, ob = rr * 64 + cc * 2; return st * 1024 + (ob ^ (((ob >> 9) & 1) << 5)); }
__host__ __device__ __forceinline__ void stage_rc(int b, int& R, int& C) { const int st = b / 1024, sb = b % 1024, swz = sb ^ (((sb >> 9) & 1) << 5); R = (st >> 1) * 16 + swz / 64; C = (st & 1) * 32 + (swz % 64) / 2; }
__host__ __device__ __forceinline__ int perm32(int rho) { const int n = rho >> 4, i = rho & 15; return 8 * (i >> 2) + 4 * n + (i & 3); }

struct Unit { int pm, pn; long long aoff, boff; };
struct Gemm { const bf16_t* A; const bf16_t* Bt; int lda, ldb, K; };

__device__ __forceinline__ void static_unit(int L, int nM, int nN, int& pm, int& pn) {
    const int nwg = nM * nN; int wgid = L; { const int q = nwg / NXCD, r = nwg % NXCD, xcd = wgid % NXCD, off = wgid / NXCD; wgid = (xcd < r ? xcd * (q + 1) : r * (q + 1) + (xcd - r) * q) + off; }
    const int nig = WGM * nN, gid = wgid / nig, fm = gid * WGM, gsz = (nM - fm) < WGM ? (nM - fm) : WGM;
    pm = fm + ((wgid % nig) % gsz); pn = (wgid % nig) / gsz;
}
template <class Epi, class Sched, bool ALIGN_EPI = false, bool SP2 = false>
__device__ __forceinline__ void gemm_phase(PG8_LAS unsigned char* lds, const Gemm g, const Sched& S, const Epi& E) {
    int tid_ = threadIdx.x; asm volatile("" : "+v"(tid_));
    const int tid = tid_, wid = __builtin_amdgcn_readfirstlane(tid >> 6), lane = tid & 63, wr = wid >> 2, wc = wid & 3, fr = lane & 15, fq = lane >> 4;
    const int K = g.K, nt = K / BK;
    unsigned voffA[2], voffB[2];
#pragma unroll
    for (int i = 0; i < 2; ++i) { int R, C; stage_rc(tid * 16 + i * 8192, R, C); const int Rb = Epi::PERM ? ((R & ~31) + perm32(R & 31)) : R;
        voffA[i] = (unsigned)(R * g.lda + C) * 2u; voffB[i] = (unsigned)(Rb * g.ldb + C) * 2u; }
    const size_t kstep = (size_t)(BK * 2);
    const size_t hstepA = (size_t)HALF * g.lda * 2, hstepB = (size_t)HALF * g.ldb * 2;
    const unsigned ldsw = (unsigned)wid * 1024u;
    const int aoff = lds_byte(wr * 64 + fr, fq * 8), boff = lds_byte(wc * 32 + fr, fq * 8);
#define PG8_SA(b, h) (((b) * 2 + (h)) * HTB)
#define PG8_SB(b, h) ((4 + (b) * 2 + (h)) * HTB)
#define PG8_STAGE(bufoff, gbase, voff) do { _Pragma("unroll") for (int _i = 0; _i < 2; ++_i) \
        __builtin_amdgcn_global_load_lds((const unsigned*)((const char*)(gbase) + (voff)[_i]), (PG8_LAS unsigned*)(lds + (bufoff) + ldsw + _i * 8192), 16, 0, 0); } while (0)
#define PG8_LDA(dst, b, h) do { _Pragma("unroll") for (int m = 0; m < 4; ++m) _Pragma("unroll") for (int k = 0; k < 2; ++k) dst[m][k] = *(const PG8_LAS bf16x8*)(lds + PG8_SA(b, h) + aoff + m * 2048 + k * 1024); } while (0)
#define PG8_LDB(dst, b, h) do { _Pragma("unroll") for (int n = 0; n < 2; ++n) _Pragma("unroll") for (int k = 0; k < 2; ++k) dst[n][k] = *(const PG8_LAS bf16x8*)(lds + PG8_SB(b, h) + boff + n * 2048 + k * 1024); } while (0)
#define PG8_MMA(ai, bj, At, Bt) do { __builtin_amdgcn_s_setprio(1); _Pragma("unroll") for (int m = 0; m < 4; ++m) _Pragma("unroll") for (int n = 0; n < 2; ++n) _Pragma("unroll") for (int k = 0; k < 2; ++k) \
        acc[ai][bj][m][n] = __builtin_amdgcn_mfma_f32_16x16x32_bf16(Bt[n][k], At[m][k], acc[ai][bj][m][n], 0, 0, 0); __builtin_amdgcn_s_setprio(0); } while (0)
#define PG8_WAIT_V(n) asm volatile("s_waitcnt vmcnt(" #n ")" ::: "memory")
#define PG8_WAIT_L(n) asm volatile("s_waitcnt lgkmcnt(" #n ")" ::: "memory")
#define PG8_BAR __builtin_amdgcn_s_barrier()
#define PG8_SCHED __builtin_amdgcn_sched_barrier(0)
    Unit cur, nxt; int ui = 0;
    if (!S.next(0, cur)) return;
    f32x4 acc[2][2][4][2];
#pragma unroll
    for (int a = 0; a < 2; ++a)
#pragma unroll
        for (int b = 0; b < 2; ++b)
#pragma unroll
            for (int m = 0; m < 4; ++m)
#pragma unroll
                for (int n = 0; n < 2; ++n) acc[a][b][m][n] = (f32x4){0.f, 0.f, 0.f, 0.f};
    bf16x8 At[4][2], B0[2][2], B1[2][2];
    const char* cA = (const char*)g.A + cur.aoff; const char* cB = (const char*)g.Bt + cur.boff;
    S.a_ready(cur);
    if constexpr (SP2) {
        PG8_STAGE(PG8_SB(0, 0), cB, voffB); PG8_STAGE(PG8_SB(0, 1), cB + hstepB, voffB); PG8_STAGE(PG8_SA(0, 0), cA, voffA); PG8_STAGE(PG8_SA(0, 1), cA + hstepA, voffA);
        if (wr == 1) PG8_BAR;
        PG8_WAIT_V(2); PG8_BAR;
        PG8_STAGE(PG8_SB(1, 0), cB + kstep, voffB); PG8_STAGE(PG8_SA(1, 0), cA + kstep, voffA); PG8_STAGE(PG8_SB(1, 1), cB + hstepB + kstep, voffB);
        PG8_WAIT_V(6); PG8_BAR;
    } else {
        PG8_STAGE(PG8_SB(0, 0), cB, voffB); PG8_STAGE(PG8_SA(0, 0), cA, voffA); PG8_STAGE(PG8_SB(0, 1), cB + hstepB, voffB); PG8_STAGE(PG8_SA(0, 1), cA + hstepA, voffA);
        if (wr == 1) PG8_BAR;
        PG8_WAIT_V(4); PG8_BAR;
        PG8_STAGE(PG8_SB(1, 0), cB + kstep, voffB); PG8_STAGE(PG8_SA(1, 0), cA + kstep, voffA); PG8_STAGE(PG8_SB(1, 1), cB + hstepB + kstep, voffB);
        PG8_WAIT_V(6); PG8_BAR;
    }
    for (;;) {
        const bool has_next = S.next(ui + 1, nxt);
        const char* nA = has_next ? (const char*)g.A + nxt.aoff : cA; const char* nB = has_next ? (const char*)g.Bt + nxt.boff : cB;
        for (int t = 0; t < nt; t += 2) {
            const bool last = (t == nt - 2);
            const char* a1 = cA + (size_t)(t + 1) * kstep;
            const char* a2 = last ? nA : cA + (size_t)(t + 2) * kstep; const char* b2 = last ? nB : cB + (size_t)(t + 2) * kstep;
            const char* a3 = a2 + kstep; const char* b3 = b2 + kstep;
            if (last && has_next) S.a_ready(nxt);
            if constexpr (SP2) {
            PG8_LDB(B0, 0, 0); PG8_LDB(B1, 0, 1); PG8_SCHED; PG8_LDA(At, 0, 0); PG8_STAGE(PG8_SA(1, 1), a1 + hstepA, voffA);
            PG8_WAIT_V(8); PG8_WAIT_L(0); PG8_BAR; PG8_MMA(0, 0, At, B0); PG8_MMA(0, 1, At, B1); PG8_BAR; PG8_SCHED;
            PG8_LDA(At, 0, 1); PG8_STAGE(PG8_SB(0, 0), b2, voffB); PG8_STAGE(PG8_SB(0, 1), b2 + hstepB, voffB); PG8_STAGE(PG8_SA(0, 0), a2, voffA);
            PG8_WAIT_V(8); PG8_WAIT_L(0); PG8_BAR; PG8_MMA(1, 0, At, B0); PG8_MMA(1, 1, At, B1); PG8_BAR; PG8_SCHED;
            PG8_LDB(B0, 1, 0); PG8_LDB(B1, 1, 1); PG8_SCHED; PG8_LDA(At, 1, 0); PG8_STAGE(PG8_SA(0, 1), a2 + hstepA, voffA);
            PG8_WAIT_V(8); PG8_WAIT_L(0); PG8_BAR; PG8_MMA(0, 0, At, B0); PG8_MMA(0, 1, At, B1); PG8_BAR; PG8_SCHED;
            PG8_LDA(At, 1, 1); PG8_STAGE(PG8_SB(1, 0), b3, voffB); PG8_STAGE(PG8_SB(1, 1), b3 + hstepB, voffB); PG8_STAGE(PG8_SA(1, 0), a3, voffA);
            PG8_WAIT_V(8); PG8_WAIT_L(0); PG8_BAR; PG8_MMA(1, 0, At, B0); PG8_MMA(1, 1, At, B1); PG8_BAR; PG8_SCHED;
            } else {
            PG8_LDB(B0, 0, 0); PG8_SCHED; PG8_LDA(At, 0, 0); PG8_STAGE(PG8_SA(1, 1), a1 + hstepA, voffA);
            PG8_WAIT_L(8); PG8_BAR; PG8_WAIT_L(0); PG8_MMA(0, 0, At, B0); PG8_BAR; PG8_SCHED;
            PG8_LDB(B1, 0, 1); PG8_STAGE(PG8_SB(0, 0), b2, voffB);
            PG8_BAR; PG8_WAIT_L(0); PG8_MMA(0, 1, At, B1); PG8_BAR;
            PG8_LDA(At, 0, 1); PG8_STAGE(PG8_SA(0, 0), a2, voffA);
            PG8_BAR; PG8_WAIT_L(0); PG8_MMA(1, 0, At, B0); PG8_BAR; PG8_SCHED;
            PG8_STAGE(PG8_SB(0, 1), b2 + hstepB, voffB);
            PG8_WAIT_V(6); PG8_BAR; PG8_MMA(1, 1, At, B1); PG8_BAR;
            PG8_LDB(B0, 1, 0); PG8_SCHED; PG8_LDA(At, 1, 0); PG8_STAGE(PG8_SA(0, 1), a2 + hstepA, voffA);
            PG8_WAIT_L(8); PG8_BAR; PG8_WAIT_L(0); PG8_MMA(0, 0, At, B0); PG8_BAR; PG8_SCHED;
            PG8_LDB(B1, 1, 1); PG8_STAGE(PG8_SB(1, 0), b3, voffB);
            PG8_BAR; PG8_WAIT_L(0); PG8_MMA(0, 1, At, B1); PG8_BAR;
            PG8_LDA(At, 1, 1); PG8_STAGE(PG8_SA(1, 0), a3, voffA);
            PG8_BAR; PG8_WAIT_L(0); PG8_MMA(1, 0, At, B0); PG8_BAR; PG8_SCHED;
            PG8_STAGE(PG8_SB(1, 1), b3 + hstepB, voffB);
            PG8_WAIT_V(6); PG8_BAR; PG8_MMA(1, 1, At, B1); PG8_BAR;
            }
        }
        if constexpr (ALIGN_EPI) { if (wr == 0) PG8_BAR; }
        if constexpr (!Epi::AFTER_DRAIN) { E(acc, cur, wr, wc, fr, fq); S.done(cur); }
        if (!has_next) break;
#pragma unroll
        for (int a = 0; a < 2; ++a)
#pragma unroll
            for (int b = 0; b < 2; ++b)
#pragma unroll
                for (int m = 0; m < 4; ++m)
#pragma unroll
                    for (int n = 0; n < 2; ++n) acc[a][b][m][n] = (f32x4){0.f, 0.f, 0.f, 0.f};
        cur = nxt; cA = nA; cB = nB; ++ui;
        if constexpr (ALIGN_EPI) { if (wr == 1) PG8_BAR; }
    }
    PG8_WAIT_V(0);
    if constexpr (!ALIGN_EPI) { if (wr == 0) PG8_BAR; }
    PG8_BAR;
    if constexpr (Epi::AFTER_DRAIN) { E.fused(acc, cur, wr, wc, fr, fq, lds, wid, lane); S.done(cur); }
#undef PG8_SA
#undef PG8_SB
#undef PG8_STAGE
#undef PG8_LDA
#undef PG8_LDB
#undef PG8_MMA
#undef PG8_WAIT_V
#undef PG8_WAIT_L
#undef PG8_BAR
#undef PG8_SCHED
}

}

using pg8::Unit; using pg8::Gemm;
typedef f32x4 Acc[2][2][4][2];

struct SchedBase { __device__ __forceinline__ void a_ready(const Unit&) const {} __device__ __forceinline__ void done(const Unit&) const {} };
struct SchedGrid : SchedBase { int nM, nN, G, c; long long atile, btile, acol;
    __device__ __forceinline__ bool next(int i, Unit& u) const { const int L = i * G + c; if (L >= nM * nN) return false; pg8::static_unit(L, nM, nN, u.pm, u.pn);
        u.aoff = (long long)u.pm * atile + (long long)u.pn * acol; u.boff = (long long)u.pn * btile; return true; } };
struct SchedOne : SchedBase { Unit u0; bool have;
    __device__ __forceinline__ bool next(int i, Unit& u) const { if (i != 0 || !have) return false; u = u0; return true; } };
struct SchedMoe : SchedBase { volatile LAS int* tp; int G, c; long long atile, bexp, btile;
    __device__ __forceinline__ bool next(int i, Unit& u) const { const int L = i * G + c; const int nt4 = tp[32] * 4; if (L >= nt4) return false; const int tile = L >> 2; u.pm = tile; u.pn = L & 3;
        int e = 0;
#pragma unroll 1
        for (int k = 1; k < 32; ++k) e += (tp[k] <= tile) ? 1 : 0;
        u.aoff = (long long)tile * atile; u.boff = (long long)e * bexp + (long long)u.pn * btile; return true; } };

#define EPI_COMMON static constexpr bool PERM = true, AFTER_DRAIN = false;
struct EpiIn { EPI_COMMON bf16* V; bf16* UG;
    __device__ __forceinline__ void operator()(const Acc& acc, const Unit& u, int wr, int wc, int fr, int fq) const {
        const int row0 = u.pm * 256 + wr * 64 + fr;
        if (u.pn < 4) {
#pragma unroll
            for (int ai = 0; ai < 2; ++ai)
#pragma unroll
                for (int m = 0; m < 4; ++m) { const int row = row0 + ai * 128 + m * 16;
                    const f32x4 v0 = acc[ai][0][m][0] * sig4(acc[ai][1][m][0]), v1 = acc[ai][0][m][1] * sig4(acc[ai][1][m][1]);
                    *(u32x4*)(V + (size_t)row * 512 + u.pn * 128 + wc * 32 + 8 * fq) = pack8(v0, v1); }
        } else {
#pragma unroll
            for (int ai = 0; ai < 2; ++ai)
#pragma unroll
                for (int m = 0; m < 4; ++m) { const int row = row0 + ai * 128 + m * 16; const int b = row >> 13, chunk = (row >> 5) & 255, j = row & 31;
#pragma unroll
                    for (int bj = 0; bj < 2; ++bj) { const int cu = (u.pn - 4) * 256 + bj * 128 + wc * 32 + 8 * fq; const int g = cu >> 4, c0 = cu & 15;
                        *(u32x4*)(UG + ((size_t)((g * 2 + b) * 256 + chunk)) * KY + j * 16 + c0) = pack8(acc[ai][bj][m][0], acc[ai][bj][m][1]); } }
        }
    } };
struct EpiKV { EPI_COMMON bf16* KP; bf16* VT;
    __device__ __forceinline__ void operator()(const Acc& acc, const Unit& u, int wr, int wc, int fr, int fq) const {
        const int row0 = u.pm * 256 + wr * 64 + fr;
#pragma unroll
        for (int ai = 0; ai < 2; ++ai)
#pragma unroll
            for (int m = 0; m < 4; ++m) { const int row = row0 + ai * 128 + m * 16;
#pragma unroll
                for (int bj = 0; bj < 2; ++bj) { const int col = bj * 128 + wc * 32 + 8 * fq;
                    if (u.pn < 4) *(u32x4*)(KP + (size_t)row * 1024 + u.pn * 256 + col) = pack8(acc[ai][bj][m][0], acc[ai][bj][m][1]);
                    else { const int b = row >> 8, key = row & 255, h = u.pn - 4; bf16* vt = VT + ((size_t)(b * 4 + h) * 256 + col) * 256 + key;
#pragma unroll
                        for (int n = 0; n < 2; ++n)
#pragma unroll
                            for (int e = 0; e < 4; ++e) vt[(n * 4 + e) * 256] = (bf16)f2bf(acc[ai][bj][m][n][e]); } } }
    } };
struct EpiScan { static constexpr bool PERM = true, AFTER_DRAIN = true; bf16* UG; const float* Are; const float* Aim; const float* logdt;
    __device__ __forceinline__ void fused(const Acc& acc, const Unit& u, int wr, int wc, int fr, int fq, LAS unsigned char* lds, int wid, int lane) const {
        LAS float* El = (LAS float*)lds;
#pragma unroll
        for (int ai = 0; ai < 2; ++ai)
#pragma unroll
            for (int m = 0; m < 4; ++m) { const int row = ai * 128 + wr * 64 + m * 16 + fr;
#pragma unroll
                for (int n = 0; n < 2; ++n) { const int cc = (wc * 32 + 8 * fq + 4 * n) >> 2; *(LAS f32x4*)(El + row * 128 + ((cc ^ (row & 31)) << 2)) = acc[ai][0][m][n]; } }
        __syncthreads();
        if (wid == 0) {
            const int g = u.pm >> 1, p = lane;
            const double dt = exp((double)logdt[g]); const double lr = (double)Are[g * NP + p] * dt * CH, li = (double)Aim[g * NP + p] * dt * CH;
            const double mag = exp(lr); double sn, cs; sincos(li, &sn, &cs);
            const float ar = (float)(mag * cs), aim = (float)(mag * sn);
            float sr = 0.f, si = 0.f;
            bf16* ug = UG + (size_t)u.pm * 256 * KY + KE;
#pragma unroll 4
            for (int ch = 0; ch < NCH; ++ch) {
                ug[(size_t)ch * KY + p] = (bf16)f2bf(sr); ug[(size_t)ch * KY + NP + p] = (bf16)f2bf(si);
                const int sw = ch & 31; const float er = El[ch * 128 + ((((p >> 2) ^ sw) << 2) | (p & 3))], ei = El[ch * 128 + (((((64 + p) >> 2) ^ sw) << 2) | (p & 3))];
                const float nr = ar * sr - aim * si + er, ni = ar * si + aim * sr + ei; sr = nr; si = ni;
            }
        }
    } };
struct EpiY { EPI_COMMON const bf16* UG; const float* Dv; bf16* Gb;
    __device__ __forceinline__ void operator()(const Acc& acc, const Unit& u, int wr, int wc, int fr, int fq) const {
        const int g = u.pm >> 1, b = u.pm & 1, i = u.pn * 16 + 4 * wc + fq;
        f32x4 dv[4];
#pragma unroll
        for (int k = 0; k < 4; ++k) dv[k] = *(const f32x4*)(Dv + g * 16 + 4 * k);
#pragma unroll
        for (int ai = 0; ai < 2; ++ai)
#pragma unroll
            for (int m = 0; m < 4; ++m) { const int chunk = ai * 128 + wr * 64 + m * 16 + fr;
                const u32x4* up = (const u32x4*)(UG + ((size_t)u.pm * 256 + chunk) * KY + i * 16);
                const size_t t = (size_t)b * SEQ + chunk * CH + i;
#pragma unroll
                for (int bj = 0; bj < 2; ++bj) { const u32x4 uw = up[bj]; f32x4 y0 = acc[ai][bj][m][0], y1 = acc[ai][bj][m][1];
                    y0[0] += dv[2 * bj][0] * bflo(uw.x); y0[1] += dv[2 * bj][1] * bfhi(uw.x); y0[2] += dv[2 * bj][2] * bflo(uw.y); y0[3] += dv[2 * bj][3] * bfhi(uw.y);
                    y1[0] += dv[2 * bj + 1][0] * bflo(uw.z); y1[1] += dv[2 * bj + 1][1] * bfhi(uw.z); y1[2] += dv[2 * bj + 1][2] * bflo(uw.w); y1[3] += dv[2 * bj + 1][3] * bfhi(uw.w);
#pragma unroll
                    for (int e = 0; e < 4; ++e) { y0[e] = gelu_tanh(y0[e]); y1[e] = gelu_tanh(y1[e]); }
                    *(u32x4*)(Gb + t * 512 + g * 16 + bj * 8) = pack8(y0, y1); } }
    } };
template <int MODE> struct EpiPair { EPI_COMMON bf16* O; int ld, coloff;
    __device__ __forceinline__ void operator()(const Acc& acc, const Unit& u, int wr, int wc, int fr, int fq) const {
        const int row0 = u.pm * 256 + wr * 64 + fr;
#pragma unroll
        for (int ai = 0; ai < 2; ++ai)
#pragma unroll
            for (int m = 0; m < 4; ++m) { const int row = row0 + ai * 128 + m * 16; f32x4 v0, v1;
                if (MODE == 0) { v0 = acc[ai][0][m][0] * sig4(acc[ai][1][m][0]); v1 = acc[ai][0][m][1] * sig4(acc[ai][1][m][1]); }
                else { v0 = acc[ai][0][m][0] * sig4(acc[ai][0][m][0]) * acc[ai][1][m][0]; v1 = acc[ai][0][m][1] * sig4(acc[ai][0][m][1]) * acc[ai][1][m][1]; }
                *(u32x4*)(O + (size_t)row * ld + coloff + u.pn * 128 + wc * 32 + 8 * fq) = pack8(v0, v1); }
    } };
struct EpiH1 { EPI_COMMON const float* X; float* OUT; bf16* H1B; float* RS1;
    __device__ __forceinline__ void operator()(const Acc& acc, const Unit& u, int wr, int wc, int fr, int fq) const {
        const int row0 = u.pm * 256 + wr * 64 + fr;
#pragma unroll
        for (int ai = 0; ai < 2; ++ai)
#pragma unroll
            for (int m = 0; m < 4; ++m) { const int row = row0 + ai * 128 + m * 16; float ss = 0.f;
#pragma unroll
                for (int bj = 0; bj < 2; ++bj) { const size_t o = (size_t)row * 1024 + u.pn * 256 + bj * 128 + wc * 32 + 8 * fq;
                    const f32x4 h0 = *(const f32x4*)(X + o) + acc[ai][bj][m][0], h1 = *(const f32x4*)(X + o + 4) + acc[ai][bj][m][1];
                    *(f32x4*)(OUT + o) = h0; *(f32x4*)(OUT + o + 4) = h1; *(u32x4*)(H1B + o) = pack8(h0, h1);
                    ss += (h0[0] * h0[0] + h0[1] * h0[1]) + (h0[2] * h0[2] + h0[3] * h0[3]) + (h1[0] * h1[0] + h1[1] * h1[1]) + (h1[2] * h1[2] + h1[3] * h1[3]); }
                ss += __shfl_xor(ss, 16); ss += __shfl_xor(ss, 32);
                if (fq == 0) RS1[(size_t)row * 16 + u.pn * 4 + wc] = ss; }
    } };
struct EpiQ { EPI_COMMON bf16* Q; const LAS float* rl;
    __device__ __forceinline__ void operator()(const Acc& acc, const Unit& u, int wr, int wc, int fr, int fq) const {
#pragma unroll
        for (int ai = 0; ai < 2; ++ai)
#pragma unroll
            for (int m = 0; m < 4; ++m) { const int rloc = ai * 128 + wr * 64 + m * 16 + fr; const float s = rl[rloc] * 0.0625f; const size_t row = (size_t)u.pm * 256 + rloc;
#pragma unroll
                for (int bj = 0; bj < 2; ++bj) *(u32x4*)(Q + row * 1024 + u.pn * 256 + bj * 128 + wc * 32 + 8 * fq) = pack8(acc[ai][bj][m][0] * s, acc[ai][bj][m][1] * s); }
    } };
struct EpiSm { static constexpr bool PERM = true, AFTER_DRAIN = true; bf16* P;
    __device__ __forceinline__ void fused(Acc& acc, const Unit& u, int wr, int wc, int fr, int fq, LAS unsigned char* lds, int wid, int lane) const {
        LAS float* Xm = (LAS float*)lds; LAS float* Xs = Xm + 1024;
#pragma unroll
        for (int ai = 0; ai < 2; ++ai)
#pragma unroll
            for (int m = 0; m < 4; ++m) { float v = -3.0e38f;
#pragma unroll
                for (int bj = 0; bj < 2; ++bj)
#pragma unroll
                    for (int n = 0; n < 2; ++n)
#pragma unroll
                        for (int e = 0; e < 4; ++e) v = fmaxf(v, acc[ai][bj][m][n][e]);
                v = fmaxf(v, __shfl_xor(v, 16)); v = fmaxf(v, __shfl_xor(v, 32));
                if (fq == 0) Xm[(ai * 128 + wr * 64 + m * 16 + fr) * 4 + wc] = v; }
        __syncthreads();
#pragma unroll
        for (int ai = 0; ai < 2; ++ai)
#pragma unroll
            for (int m = 0; m < 4; ++m) { const f32x4 q = *(const LAS f32x4*)(Xm + (ai * 128 + wr * 64 + m * 16 + fr) * 4); const float rm = fmaxf(fmaxf(q[0], q[1]), fmaxf(q[2], q[3])); float s = 0.f;
#pragma unroll
                for (int bj = 0; bj < 2; ++bj)
#pragma unroll
                    for (int n = 0; n < 2; ++n)
#pragma unroll
                        for (int e = 0; e < 4; ++e) { const float pe = __expf(acc[ai][bj][m][n][e] - rm); acc[ai][bj][m][n][e] = pe; s += pe; }
                s += __shfl_xor(s, 16); s += __shfl_xor(s, 32);
                if (fq == 0) Xs[(ai * 128 + wr * 64 + m * 16 + fr) * 4 + wc] = s; }
        __syncthreads();
#pragma unroll
        for (int ai = 0; ai < 2; ++ai)
#pragma unroll
            for (int m = 0; m < 4; ++m) { const int rloc = ai * 128 + wr * 64 + m * 16 + fr; const f32x4 q = *(const LAS f32x4*)(Xs + rloc * 4); const float inv = __builtin_amdgcn_rcpf((q[0] + q[1]) + (q[2] + q[3]));
                const size_t row = (size_t)u.pm * 256 + rloc;
#pragma unroll
                for (int bj = 0; bj < 2; ++bj) *(u32x4*)(P + row * 1024 + u.pn * 256 + bj * 128 + wc * 32 + 8 * fq) = pack8(acc[ai][bj][m][0] * inv, acc[ai][bj][m][1] * inv); }
    } };
struct EpiBf { EPI_COMMON bf16* O; int ld;
    __device__ __forceinline__ void operator()(const Acc& acc, const Unit& u, int wr, int wc, int fr, int fq) const {
        const int row0 = u.pm * 256 + wr * 64 + fr;
#pragma unroll
        for (int ai = 0; ai < 2; ++ai)
#pragma unroll
            for (int m = 0; m < 4; ++m) { const int row = row0 + ai * 128 + m * 16;
#pragma unroll
                for (int bj = 0; bj < 2; ++bj) *(u32x4*)(O + (size_t)row * ld + u.pn * 256 + bj * 128 + wc * 32 + 8 * fq) = pack8(acc[ai][bj][m][0], acc[ai][bj][m][1]); }
    } };
struct EpiH2 { EPI_COMMON float* OUT;
    __device__ __forceinline__ void operator()(const Acc& acc, const Unit& u, int wr, int wc, int fr, int fq) const {
        const int row0 = u.pm * 256 + wr * 64 + fr;
#pragma unroll
        for (int ai = 0; ai < 2; ++ai)
#pragma unroll
            for (int m = 0; m < 4; ++m) { const int row = row0 + ai * 128 + m * 16;
#pragma unroll
                for (int bj = 0; bj < 2; ++bj) { float* o = OUT + (size_t)row * 1024 + u.pn * 256 + bj * 128 + wc * 32 + 8 * fq;
                    const f32x4 h0 = *(const f32x4*)o + acc[ai][bj][m][0], h1 = *(const f32x4*)(o + 4) + acc[ai][bj][m][1]; *(f32x4*)o = h0; *(f32x4*)(o + 4) = h1; } }
    } };
struct EpiDown { EPI_COMMON bf16* Y; const float* gate;
    __device__ __forceinline__ void operator()(const Acc& acc, const Unit& u, int wr, int wc, int fr, int fq) const {
        const int row0 = u.pm * 256 + wr * 64 + fr;
#pragma unroll
        for (int ai = 0; ai < 2; ++ai)
#pragma unroll
            for (int m = 0; m < 4; ++m) { const int row = row0 + ai * 128 + m * 16; const float gt = gate[row];
#pragma unroll
                for (int bj = 0; bj < 2; ++bj) *(u32x4*)(Y + (size_t)row * 1024 + u.pn * 256 + bj * 128 + wc * 32 + 8 * fq) = pack8(acc[ai][bj][m][0] * gt, acc[ai][bj][m][1] * gt); }
    } };

#define XB_TMO      128
#define XB_XCNT(j)  (256  + 64 * (j))
#define XB_XSUB(j)  (1280 + 64 * (j))
#define XB_XGEN(j)  (2304 + 64 * (j))
#define XB_TOP      3328
#define XB_TOPGEN   3392
#define XCD_BAR_WORDS 3456
#define XB_SPIN_CAP (1u << 18)

__device__ __forceinline__ unsigned xb_ld(unsigned* p)              { return __hip_atomic_load(p, __ATOMIC_RELAXED, __HIP_MEMORY_SCOPE_AGENT); }
__device__ __forceinline__ unsigned xb_add(unsigned* p, unsigned v) { return __hip_atomic_fetch_add(p, v, __ATOMIC_RELAXED, __HIP_MEMORY_SCOPE_AGENT); }
__device__ __forceinline__ unsigned xb_xcc_id() { return (unsigned)__builtin_amdgcn_s_getreg((3 << 11) | 20) & 0xFu; }
#define XB_SPIN(cond, bar) do { unsigned _sp = 0; while (cond) { __builtin_amdgcn_s_sleep(1); \
    if ((++_sp & 255u) == 0u) { if (xb_ld(&(bar)[XB_TMO])) break; if (_sp > XB_SPIN_CAP) { atomicAdd(&(bar)[XB_TMO], 1u); break; } } } } while (0)

struct XcdBarrier {
    unsigned* bar; unsigned x;
    volatile LAS unsigned* st;
};

__device__ __forceinline__ XcdBarrier xcd_barrier_post(unsigned* bar, volatile LAS unsigned* st) {
    XcdBarrier b; b.bar = bar; b.x = xb_xcc_id(); b.st = st;
    if (threadIdx.x == 0) (void)xb_add(&bar[XB_XCNT(b.x)], 1u);
    return b;
}
__device__ __forceinline__ void xcd_barrier_complete(unsigned* bar, unsigned x, unsigned& nloc, unsigned& nx) {
    const unsigned G = gridDim.x * gridDim.y * gridDim.z;
    unsigned sum, cnt, mine, sp = 0u;
    for (;;) {
        sum = 0u; cnt = 0u; mine = 0u;
#pragma unroll
        for (unsigned j = 0; j < 16; ++j) { const unsigned c = xb_ld(&bar[XB_XCNT(j)]); sum += c; cnt += (c > 0u) ? 1u : 0u; mine = (j == x) ? c : mine; }
        if (sum == G) break;
        __builtin_amdgcn_s_sleep(1);
        if ((++sp & 255u) == 0u) { if (xb_ld(&bar[XB_TMO])) break; if (sp > XB_SPIN_CAP) { atomicAdd(&bar[XB_TMO], 1u); break; } }
    }
    nloc = mine > 0u ? mine : 1u; nx = cnt > 0u ? cnt : 1u;
}

__device__ __forceinline__ void xcd_barrier(const XcdBarrier& b) {
    asm volatile("s_waitcnt vmcnt(0)" ::: "memory");
    __syncthreads();
    if (threadIdx.x == 0) {
        unsigned* bar = b.bar;
        __builtin_amdgcn_s_waitcnt(0);
        unsigned nloc = b.st[0], nx = b.st[1];
        if (nloc == 0u) { xcd_barrier_complete(bar, b.x, nloc, nx); b.st[0] = nloc; b.st[1] = nx; }
        const unsigned old = xb_add(&bar[XB_XSUB(b.x)], 1u);
        const unsigned gen = old / nloc;
        if (old + 1u == (gen + 1u) * nloc) {
            __builtin_amdgcn_fence(__ATOMIC_RELEASE, "agent");
            asm volatile("s_waitcnt vmcnt(0)" ::: "memory");
            const unsigned og = xb_add(&bar[XB_TOP], 1u);
            const unsigned tg = og / nx;
            if (og + 1u == (tg + 1u) * nx) xb_add(&bar[XB_TOPGEN], 1u);
            else XB_SPIN(xb_ld(&bar[XB_TOPGEN]) == tg, bar);
            __builtin_amdgcn_fence(__ATOMIC_ACQUIRE, "agent");
            xb_add(&bar[XB_XGEN(b.x)], 1u);
            asm volatile("s_waitcnt vmcnt(0)" ::: "memory");
        } else {
            XB_SPIN(xb_ld(&bar[XB_XGEN(b.x)]) == gen, bar);
            __builtin_amdgcn_fence(__ATOMIC_ACQUIRE, "agent");
            asm volatile("s_waitcnt vmcnt(0)" ::: "memory");
        }
    }
    __syncthreads();
}

__device__ __forceinline__ void transpose_item(const float* W, int ldw, bf16* WT, int ldwt, int k0, int n0, int dst_row0, const float* kscale, LAS float* scr, int lane) {
#pragma unroll 8
    for (int i = 0; i < 32; ++i) { const int kk = 2 * i + (lane >> 5); float v = W[(size_t)(k0 + kk) * ldw + n0 + (lane & 31)]; if (kscale) v *= kscale[k0 + kk]; scr[kk * 33 + (lane & 31)] = v; }
    LDS_WAIT(); asm volatile("" ::: "memory");
    const int c = lane & 7;
#pragma unroll
    for (int j = 0; j < 4; ++j) { const int n = (lane >> 3) + 8 * j; const LAS float* s = scr + (8 * c) * 33 + n;
        u32x4 o; o.x = pk2(s[0 * 33], s[1 * 33]); o.y = pk2(s[2 * 33], s[3 * 33]); o.z = pk2(s[4 * 33], s[5 * 33]); o.w = pk2(s[6 * 33], s[7 * 33]);
        *(u32x4*)(WT + (size_t)(dst_row0 + n) * ldwt + k0 + 8 * c) = o; }
    LDS_WAIT(); asm volatile("" ::: "memory");
}
__device__ __forceinline__ void rms_row_to_bf16(const float* xrow, const float* gain, bf16* orow, int lane) {
    f32x4 v[4]; float s = 0.f;
#pragma unroll
    for (int j = 0; j < 4; ++j) { v[j] = *(const f32x4*)(xrow + (lane + 64 * j) * 4); s += (v[j][0] * v[j][0] + v[j][1] * v[j][1]) + (v[j][2] * v[j][2] + v[j][3] * v[j][3]); }
    const float r = 1.0f / sqrtf(wave_sum(s) * (1.f / D) + EPS);
#pragma unroll
    for (int j = 0; j < 4; ++j) { const f32x4 gn = *(const f32x4*)(gain + (lane + 64 * j) * 4); u32x2 o; o.x = pk2(v[j][0] * r * gn[0], v[j][1] * r * gn[1]); o.y = pk2(v[j][2] * r * gn[2], v[j][3] * r * gn[3]);
        *(u32x2*)(orow + (lane + 64 * j) * 4) = o; }
}
__device__ __forceinline__ void ssm_consts(const float* Are, const float* Aim, const float* logdt, int g, int p, double& lr, double& li, double& cr, double& ci) {
    const double dt = exp((double)logdt[g]), a = (double)Are[g * NP + p], b = (double)Aim[g * NP + p];
    lr = a * dt; li = b * dt;
    const double mag = exp(lr); double sn, cs; sincos(li, &sn, &cs);
    const double x = mag * cs - 1.0, y = mag * sn, den = a * a + b * b;
    cr = (x * a + y * b) / den; ci = (y * a - x * b) / den;
}
__device__ __forceinline__ void cpow_d(double lr, double li, int m, float& zr, float& zi) { const double mag = exp(lr * m); double sn, cs; sincos(li * m, &sn, &cs); zr = (float)(mag * cs); zi = (float)(mag * sn); }

struct Args { const float* in[33]; float* out; unsigned char* ws; int ph_lo, ph_hi; };

template <int NS> __device__ __forceinline__ void conv_block(float (&win)[CWID], const float (&w)[CWID], const bf16* vcol, float bias, LAS float* outl) {
#pragma unroll
    for (int ss = 0; ss < NS; ++ss) {
        win[ss % CWID] = bf2f(vcol[(size_t)ss * 512]);
        float a = bias;
#pragma unroll
        for (int k = 0; k < CWID; ++k) a += w[k] * win[(ss + k + 1) % CWID];
        outl[ss * 512] = a;
    }
}

__device__ __forceinline__ int toep_col(int i, int c) { return (i >> 4) * 256 + (c >> 3) * 128 + (i & 15) * 8 + (c & 7); }


#define X (args.in[0])
#define OUT (args.out)
#define WSP(T_, off) ((T_*)(ws + (off)))
#define WIN_T WSP(bf16, WS_WIN)
#define WOUT_T WSP(bf16, WS_WOUT)
#define WQ_T WSP(bf16, WS_WQ)
#define WKV_T WSP(bf16, WS_WKV)
#define WO_T WSP(bf16, WS_WO)
#define TOEP WSP(bf16, WS_TOEP)
#define ETAB WSP(bf16, WS_ETAB)
#define GLUBT WSP(bf16, WS_GLUBT)
#define MEMN WSP(bf16, WS_MEMN)
#define KPROJ WSP(bf16, WS_KPROJ)
#define VT WSP(bf16, WS_VT)
#define WUP_T WSP(bf16, WS_WUP)
#define WDN_T WSP(bf16, WS_WDN)
#define HN WSP(bf16, WS_HN)
#define VBUF WSP(bf16, WS_VBUF)
#define UG WSP(bf16, WS_UG)
#define CONCAT WSP(bf16, WS_CONCAT)
#define GB WSP(bf16, WS_G)
#define H1B WSP(bf16, WS_H1B)
#define QBUF WSP(bf16, WS_QBUF)
#define PBUF WSP(bf16, WS_PBUF)
#define OBUF WSP(bf16, WS_OBUF)
#define XG WSP(bf16, WS_XG)
#define HID WSP(bf16, WS_HID)
#define HIST WSP(int, WS_HIST)
#define TPREF WSP(int, WS_TPREF)
#define TOKE WSP(int, WS_TOKE)
#define TOKG WSP(float, WS_TOKG)
#define TOKS WSP(int, WS_TOKS)
#define RSTD3 WSP(float, WS_RSTD3)
#define SGATE WSP(float, WS_SGATE)
#define RS1 WSP(float, WS_RS1)
#define W36 WSP(float, WS_W36)
#define SSMC WSP(float, WS_KMAT)
__global__ void __launch_bounds__(NTHR, 2) mk_fwd(Args args) {
    extern __shared__ __attribute__((aligned(16))) unsigned char lds_raw[];
    LAS unsigned char* lds = (LAS unsigned char*)lds_raw;
    const int tid = threadIdx.x, lane = tid & 63, wave = __builtin_amdgcn_readfirstlane(tid >> 6);
    const int G = gridDim.x, c = blockIdx.x;
    const int vcu = (G % 8 == 0) ? (c % 8) * (G / 8) + c / 8 : c;
    const int gw = vcu * NWAVES + wave, NGW = G * NWAVES;
    unsigned char* ws = args.ws;
    volatile LAS unsigned* LCTL = (volatile LAS unsigned*)(lds + LCTL_OFF);
    for (int u = tid; u < 128; u += NTHR) LCTL[u] = 0u;
    __syncthreads();
    XcdBarrier bar; bar.bar = (unsigned*)(ws + WS_CTL) + CW_BAR; bar.x = 0; bar.st = nullptr;
    if (!MK_PER_PHASE) bar = xcd_barrier_post((unsigned*)(ws + WS_CTL) + CW_BAR, LCTL + 8);
#define GRID_BAR() do { if (!MK_PER_PHASE) xcd_barrier(bar); } while (0)
    const int lo = args.ph_lo, hi = args.ph_hi;
#ifndef PH_MASK
#define PH_MASK 0x1fff
#endif
#define IN(k) (((PH_MASK >> (k)) & 1) && lo <= (k) && (k) < hi)
#define BOTH(k) (IN(k) && IN((k) + 1))
#define PHASE(k) if (IN(k))

    PHASE(0) {
        const int gt = gw * 64 + lane, NGT = NGW * 64;
        for (int idx = gt; idx < NG * NP; idx += NGT) { const int g = idx >> 6, p = idx & 63; double lr, li, cr, ci; ssm_consts(args.in[8], args.in[9], args.in[10], g, p, lr, li, cr, ci);
            float ar, ai; cpow_d(lr, li, 1, ar, ai); float* o = SSMC + (size_t)idx * 8; o[0] = (float)lr; o[1] = (float)li; o[2] = (float)cr; o[3] = (float)ci; o[4] = ar; o[5] = ai; o[6] = 0.f; o[7] = 0.f; }
        for (int idx = gt; idx < 4 * 256 * 128; idx += NGT) { const int pn = idx >> 15, np = (idx >> 7) & 255, k = idx & 127; const int bj = np >> 7, gl = (np >> 4) & 7, e = np & 15; const int g = pn * 8 + gl;
            const float v = ((k >> 4) == gl) ? args.in[16][(size_t)(g * 16 + (k & 15)) * 32 + bj * 16 + e] : 0.f; GLUBT[idx] = (bf16)f2bf(v); }
        for (int idx = gt; idx < D * NCOLR; idx += NGT) { const int k = idx / NCOLR, q = idx % NCOLR; W36[idx] = args.in[24][k] * (q < 4 ? args.in[25][k * 4 + q] : args.in[27][k * 32 + q - 4]); }
        for (int m = gw; m < T; m += NGW) rms_row_to_bf16(X + (size_t)m * D, args.in[2], HN + (size_t)m * D, lane);
        for (int m = gw; m < TM; m += NGW) rms_row_to_bf16(args.in[1] + (size_t)m * D, args.in[19], MEMN + (size_t)m * D, lane);
        LAS float* scr = (LAS float*)(lds + wave * 16384);
        constexpr int I_IN = 16 * 48, I_SQ = 16 * 32, I_E = 768, NITEMS = I_IN + 5 * I_SQ + NE * I_E;
        for (int it = gw; it < NITEMS; it += NGW) {
            int r = it;
            if (r < I_IN) { const int kb = r / 48, nb = r % 48, n0 = nb * 32; const int dst = (n0 < 1024) ? (((n0 & 511) >> 7) * 256 + (n0 >> 9) * 128 + (n0 & 127)) : n0;
                transpose_item(args.in[3], 1536, WIN_T, 1024, kb * 64, n0, dst, nullptr, scr, lane); continue; } r -= I_IN;
            if (r < 5 * I_SQ) { const int w = r / I_SQ, q = r % I_SQ, kb = q / 32, n0 = (q % 32) * 32;
                const float* src = (w == 0) ? args.in[17] : (w == 1) ? args.in[20] : (w == 2) ? args.in[21] : (w == 3) ? args.in[22] : args.in[23];
                bf16* dstp = (w == 0) ? WOUT_T : (w == 1) ? WQ_T : (w == 2) ? WKV_T : (w == 3) ? WKV_T + (size_t)1024 * 1024 : WO_T;
                transpose_item(src, 1024, dstp, 1024, kb * 64, n0, n0, (w == 1) ? args.in[18] : nullptr, scr, lane); continue; } r -= 5 * I_SQ;
            { const int e = r / I_E, q = r % I_E;
              if (q < 512) { const int which = q >> 8, qq = q & 255, kb = qq >> 4, n0 = (qq & 15) * 32;
                  transpose_item((which ? args.in[30] : args.in[29]) + (size_t)e * 1024 * 512, 512, WUP_T + (size_t)e * 1024 * 1024, 1024, kb * 64, n0, (n0 >> 7) * 256 + which * 128 + (n0 & 127), nullptr, scr, lane); }
              else { const int qq = q - 512, kb = qq >> 5, n0 = (qq & 31) * 32;
                  transpose_item(args.in[31] + (size_t)e * 512 * 1024, 1024, WDN_T + (size_t)e * 1024 * 512, 512, kb * 64, n0, n0, nullptr, scr, lane); } }
        }
        if (BOTH(0)) GRID_BAR();
    }

    PHASE(1) {
        { Gemm g{HN, WIN_T, 1024, 1024, 1024}; SchedGrid S; S.nM = 64; S.nN = 6; S.G = G; S.c = c; S.atile = 256ll * 1024 * 2; S.btile = 256ll * 1024 * 2; S.acol = 0;
          EpiIn E{VBUF, UG}; pg8::gemm_phase<EpiIn, SchedGrid, true, true>(lds, g, S, E); }
        if (c >= 128) {
            if (c < 144) { Gemm g{MEMN, WKV_T, 1024, 1024, 1024}; SchedOne S; const int L = c - 128; S.have = true; S.u0.pm = L >> 3; S.u0.pn = L & 7; S.u0.aoff = (long long)(L >> 3) * 256 * 1024 * 2; S.u0.boff = (long long)(L & 7) * 256 * 1024 * 2;
                EpiKV E{KPROJ, VT}; pg8::gemm_phase<EpiKV, SchedOne, true, true>(lds, g, S, E); }
            if (c >= 144) {
            const int sidx = (c - 144) * NTHR + tid, NS = 112 * NTHR;
            const float* Bre = args.in[11]; const float* Bim = args.in[12]; const float* Cre = args.in[13]; const float* Cim = args.in[14];
            for (int idx = sidx; idx < NG * 128; idx += NS) { const int g = idx >> 7, q = idx & 127, p = q & 63; const float* sc = SSMC + (size_t)(g * NP + p) * 8;
                float zr = sc[2], zi = sc[3]; const float ar = sc[4], ai = sc[5];
                f32x4 br[4], bi[4];
#pragma unroll
                for (int k = 0; k < 4; ++k) { br[k] = *(const f32x4*)(Bre + (size_t)(g * NP + p) * 16 + 4 * k); bi[k] = *(const f32x4*)(Bim + (size_t)(g * NP + p) * 16 + 4 * k); }
                for (int j = CH - 1; j >= 0; --j) { f32x4 o[4];
#pragma unroll
                    for (int k = 0; k < 4; ++k) o[k] = (q < 64) ? (br[k] * zr - bi[k] * zi) : (bi[k] * zr + br[k] * zi);
                    bf16* d = ETAB + (size_t)(g * 128 + q) * KE + j * 16; *(u32x4*)d = pack8(o[0], o[1]); *(u32x4*)(d + 8) = pack8(o[2], o[3]);
                    const float t = zr * ar - zi * ai; zi = zr * ai + zi * ar; zr = t; } }
            for (int idx = sidx; idx < NG * 16 * NP; idx += NS) { const int g = idx >> 10, cch = (idx >> 6) & 15, p = idx & 63; const float* sc = SSMC + (size_t)(g * NP + p) * 8; const float ar = sc[4], ai = sc[5];
                const float cr = Cre[(size_t)(g * 16 + cch) * NP + p], ci = Cim[(size_t)(g * 16 + cch) * NP + p]; float zr = cr * ar - ci * ai, zi = cr * ai + ci * ar;
                for (int i = 0; i < CH; ++i) { bf16* d = TOEP + (size_t)(g * 512 + toep_col(i, cch)) * KY + KE; d[p] = (bf16)f2bf(zr); d[NP + p] = (bf16)f2bf(-zi);
                    const float t = zr * ar - zi * ai; zi = zr * ai + zi * ar; zr = t; } }
            for (int idx = sidx; idx < NG * 256 * 4; idx += NS) { const int pq = idx & 3, cc = (idx >> 2) & 255, g = idx >> 10, c1 = cc >> 4, c2 = cc & 15;
                float ks[CH];
#pragma unroll
                for (int l = 0; l < CH; ++l) ks[l] = 0.f;
                for (int pp = 0; pp < 16; ++pp) { const int p = pq * 16 + pp; const float* sc = SSMC + (size_t)(g * NP + p) * 8;
                    const float br = Bre[(size_t)(g * NP + p) * 16 + c2], bi = Bim[(size_t)(g * NP + p) * 16 + c2], bbr = sc[2] * br - sc[3] * bi, bbi = sc[2] * bi + sc[3] * br;
                    const float cr = Cre[(size_t)(g * 16 + c1) * NP + p], ci = Cim[(size_t)(g * 16 + c1) * NP + p]; float zr = cr * bbr - ci * bbi, zi = cr * bbi + ci * bbr; const float ar = sc[4], ai = sc[5];
#pragma unroll
                    for (int l = 0; l < CH; ++l) { ks[l] += zr; const float t = zr * ar - zi * ai; zi = zr * ai + zi * ar; zr = t; } }
#pragma unroll
                for (int l = 0; l < CH; ++l) { ks[l] += __shfl_xor(ks[l], 1); ks[l] += __shfl_xor(ks[l], 2); }
#pragma unroll
                for (int l = 0; l < CH; ++l) if ((l & 3) == pq) { const bf16 v = (bf16)f2bf(ks[l]);
                    for (int i = l; i < CH; ++i) TOEP[(size_t)(g * 512 + toep_col(i, c1)) * KY + (i - l) * 16 + c2] = v; } }
            for (int idx = sidx; idx < NG * 512 * CH; idx += NS) { const int g = idx >> 14, n = (idx >> 5) & 511, j = idx & 31; const int i = (n >> 8) * 16 + ((n >> 3) & 15);
                if (j > i) { bf16* d = TOEP + (size_t)(g * 512 + n) * KY + j * 16; const u32x4 z = {0u, 0u, 0u, 0u}; *(u32x4*)d = z; *(u32x4*)(d + 8) = z; } }
            }
        }
        if (BOTH(1)) GRID_BAR();
    }

    PHASE(2) {
        if (c < 64) { Gemm g{UG, ETAB, KY, KE, KE}; SchedOne S; S.have = true; S.u0.pm = c; S.u0.pn = 0; S.u0.aoff = (long long)c * 256 * KY * 2; S.u0.boff = (long long)(c >> 1) * 128 * KE * 2;
            EpiScan E{UG, args.in[8], args.in[9], args.in[10]}; pg8::gemm_phase<EpiScan, SchedOne, false, true>(lds, g, S, E); }
        else {
            const int ch = tid; float w[CWID];
#pragma unroll
            for (int k = 0; k < CWID; ++k) w[k] = args.in[4][k * DCONV + ch];
            const float bias = args.in[5][ch];
            LAS float* outl = (LAS float*)lds;
            for (int tile = c - 64; tile < T / 64; tile += G - 64) {
                const int t0 = tile * 64, tb0 = (t0 >> 13) << 13; float win[CWID];
                win[0] = 0.f;
#pragma unroll
                for (int i = 0; i < CWID - 1; ++i) { const int tt = t0 - (CWID - 1) + i; win[i + 1] = (tt >= tb0) ? bf2f(VBUF[(size_t)tt * 512 + ch]) : 0.f; }
                conv_block<31>(win, w, VBUF + (size_t)t0 * 512 + ch, bias, outl + ch);
                conv_block<31>(win, w, VBUF + (size_t)(t0 + 31) * 512 + ch, bias, outl + 31 * 512 + ch);
                conv_block<2>(win, w, VBUF + (size_t)(t0 + 62) * 512 + ch, bias, outl + 62 * 512 + ch);
                __syncthreads();
                for (int r = 0; r < 8; ++r) { const int tok = wave * 8 + r; float v[8]; float s = 0.f;
#pragma unroll
                    for (int j = 0; j < 8; ++j) { v[j] = outl[tok * 512 + lane + 64 * j]; s += v[j]; }
                    const float mean = wave_sum(s) * (1.f / 512.f); float q = 0.f;
#pragma unroll
                    for (int j = 0; j < 8; ++j) { v[j] -= mean; q += v[j] * v[j]; }
                    const float rstd = 1.0f / sqrtf(wave_sum(q) * (1.f / 512.f) + EPS);
#pragma unroll
                    for (int j = 0; j < 8; ++j) { const int cch = lane + 64 * j; const float o = v[j] * rstd * args.in[6][cch] + args.in[7][cch]; CONCAT[(size_t)(t0 + tok) * 1024 + cch] = (bf16)f2bf(o * sigmoidf_(o)); } }
                __syncthreads();
            }
        }
        if (BOTH(2)) GRID_BAR();
    }

    PHASE(3) {
        if (c < 128) { const int g = c >> 2, b = (c >> 1) & 1, pn = c & 1; Gemm gm{UG, TOEP, KY, KY, KY}; SchedOne S; S.have = true; S.u0.pm = g * 2 + b; S.u0.pn = pn;
            S.u0.aoff = (long long)(g * 2 + b) * 256 * KY * 2; S.u0.boff = (long long)(g * 512 + pn * 256) * KY * 2;
            EpiY E{UG, args.in[15], GB}; pg8::gemm_phase<EpiY, SchedOne, true, true>(lds, gm, S, E); }
        if (BOTH(3)) GRID_BAR();
    }

    PHASE(4) {
        { Gemm g{GB, GLUBT, 512, 128, 128}; SchedGrid S; S.nM = 64; S.nN = 4; S.G = G; S.c = c; S.atile = 256ll * 512 * 2; S.btile = 256ll * 128 * 2; S.acol = 128 * 2;
          EpiPair<0> E{CONCAT, 1024, 512}; pg8::gemm_phase<EpiPair<0>, SchedGrid, true, true>(lds, g, S, E); }
        if (BOTH(4)) GRID_BAR();
    }

    PHASE(5) {
        { Gemm g{CONCAT, WOUT_T, 1024, 1024, 1024}; SchedGrid S; S.nM = 64; S.nN = 4; S.G = G; S.c = c; S.atile = 256ll * 1024 * 2; S.btile = 256ll * 1024 * 2; S.acol = 0;
          EpiH1 E{X, OUT, H1B, RS1}; pg8::gemm_phase<EpiH1, SchedGrid, true, true>(lds, g, S, E); }
        if (BOTH(5)) GRID_BAR();
    }

    PHASE(6) {
        if (c < 256) {
            int pm, pn; pg8::static_unit(c, 64, 4, pm, pn); const int b = pm >> 5, h = pn;
            LAS float* rl = (LAS float*)(lds + EXT_OFF);
            for (int r = tid; r < 256; r += NTHR) { const float* p = RS1 + ((size_t)pm * 256 + r) * 16; float s = 0.f;
#pragma unroll
                for (int j = 0; j < 4; ++j) { const f32x4 v = *(const f32x4*)(p + 4 * j); s += (v[0] + v[1]) + (v[2] + v[3]); }
                rl[r] = 1.0f / sqrtf(s * (1.f / D) + EPS); }
            __syncthreads();
            SchedOne S; S.have = true; S.u0.pm = pm; S.u0.pn = pn;
            { Gemm g{H1B, WQ_T, 1024, 1024, 1024}; S.u0.aoff = (long long)pm * 256 * 1024 * 2; S.u0.boff = (long long)pn * 256 * 1024 * 2;
              EpiQ E{QBUF, rl}; pg8::gemm_phase<EpiQ, SchedOne, true, true>(lds, g, S, E); }
            VM_WAIT(); __syncthreads();
            { Gemm g{QBUF, KPROJ, 1024, 1024, 256}; S.u0.aoff = ((long long)pm * 256 * 1024 + h * 256) * 2; S.u0.boff = ((long long)b * 256 * 1024 + h * 256) * 2;
              EpiSm E{PBUF}; pg8::gemm_phase<EpiSm, SchedOne, false, true>(lds, g, S, E); }
            VM_WAIT(); __syncthreads();
            { Gemm g{PBUF, VT, 1024, 256, 256}; S.u0.aoff = ((long long)pm * 256 * 1024 + h * 256) * 2; S.u0.boff = (long long)(b * 4 + h) * 65536 * 2;
              EpiBf E{OBUF, 1024}; pg8::gemm_phase<EpiBf, SchedOne, true, true>(lds, g, S, E); }
        }
        if (BOTH(6)) GRID_BAR();
    }

    PHASE(7) {
        { Gemm g{OBUF, WO_T, 1024, 1024, 1024}; SchedGrid S; S.nM = 64; S.nN = 4; S.G = G; S.c = c; S.atile = 256ll * 1024 * 2; S.btile = 256ll * 1024 * 2; S.acol = 0;
          EpiH2 E{OUT}; pg8::gemm_phase<EpiH2, SchedGrid, true, true>(lds, g, S, E); }
        if (BOTH(7)) GRID_BAR();
    }

    PHASE(8) {
        for (int blk = c; blk < T / 64; blk += G) {
            const int t0 = blk * 64;
            LAS float* Xs = (LAS float*)lds;
            LAS float* Ws = (LAS float*)(lds + 66048);
            float av[NCOLR + 1];
#pragma unroll
            for (int k = 0; k <= NCOLR; ++k) av[k] = 0.f;
            for (int kp = 0; kp < 4; ++kp) {
#pragma unroll
                for (int it = 0; it < 8; ++it) { const int idx = it * NTHR + tid, tok = idx >> 6, kq = (idx & 63) * 4; const f32x4 v = *(const f32x4*)(OUT + (size_t)(t0 + tok) * 1024 + kp * 256 + kq);
                    LAS float* d = Xs + tok * 257 + kq; d[0] = v[0]; d[1] = v[1]; d[2] = v[2]; d[3] = v[3]; }
                for (int idx = tid; idx < 256 * NCOLR / 4; idx += NTHR) *(LAS f32x4*)(Ws + idx * 4) = *(const f32x4*)(W36 + (size_t)kp * 256 * NCOLR + idx * 4);
                __syncthreads();
#pragma unroll 2
                for (int kk = 0; kk < 32; ++kk) { const int kl = wave * 32 + kk; const float x = Xs[lane * 257 + kl]; av[NCOLR] += x * x; const LAS f32x4* wr = (const LAS f32x4*)(Ws + kl * NCOLR);
#pragma unroll
                    for (int q = 0; q < 9; ++q) { const f32x4 wv = wr[q]; av[4 * q] += x * wv[0]; av[4 * q + 1] += x * wv[1]; av[4 * q + 2] += x * wv[2]; av[4 * q + 3] += x * wv[3]; } }
                __syncthreads();
            }
            LAS float* Part = (LAS float*)lds;
#pragma unroll
            for (int q = 0; q <= NCOLR; ++q) Part[(wave * (NCOLR + 1) + q) * 64 + lane] = av[q];
            LAS float* Lg = (LAS float*)(lds + EXT_OFF + 1024);
            LAS int* lh = (LAS int*)(lds + EXT_OFF + 1024 + 64 * 40 * 4);
            if (tid < 32) lh[tid] = 0;
            __syncthreads();
            for (int idx = tid; idx < 64 * (NCOLR + 1); idx += NTHR) { const int tok = idx & 63, q = idx >> 6; float s = 0.f;
#pragma unroll
                for (int w8 = 0; w8 < 8; ++w8) s += Part[(w8 * (NCOLR + 1) + q) * 64 + tok];
                Lg[tok * 40 + q] = s; }
            __syncthreads();
            if (tid < 64) { const int t = t0 + tid; const LAS float* L = Lg + tid * 40; const float rstd = 1.0f / sqrtf(L[NCOLR] * (1.f / D) + EPS); RSTD3[t] = rstd;
                float gl[4]; int gi = 0; float gm;
#pragma unroll
                for (int q = 0; q < 4; ++q) gl[q] = L[q] * rstd + args.in[26][q];
                gm = gl[0];
#pragma unroll
                for (int q = 1; q < 4; ++q) if (gl[q] > gm) { gm = gl[q]; gi = q; }
                float gs = 0.f;
#pragma unroll
                for (int q = 0; q < 4; ++q) gs += expf(gl[q] - gm);
                const float gwt = 1.0f / gs;
                float el[8];
#pragma unroll
                for (int q = 0; q < 8; ++q) el[q] = L[4 + gi * 8 + q] * rstd + args.in[28][gi * 8 + q];
                int i1 = 0; float l1 = el[0];
#pragma unroll
                for (int q = 1; q < 8; ++q) if (el[q] > l1) { l1 = el[q]; i1 = q; }
                int i2 = -1; float l2 = -3.0e38f;
#pragma unroll
                for (int q = 0; q < 8; ++q) if (q != i1 && el[q] > l2) { l2 = el[q]; i2 = q; }
                const float p2 = 1.0f / (1.0f + expf(l1 - l2)), p1 = 1.0f - p2;
                const int e1 = gi * 8 + i1, e2 = gi * 8 + i2;
                TOKE[t * 2] = e1; TOKE[t * 2 + 1] = e2; TOKG[t * 2] = gwt * p1; TOKG[t * 2 + 1] = gwt * p2;
                atomicAdd((int*)&lh[e1], 1); atomicAdd((int*)&lh[e2], 1); }
            __syncthreads();
            if (tid < 32) HIST[blk * 32 + tid] = lh[tid];
            __syncthreads();
        }
        if (BOTH(8)) GRID_BAR();
    }

    PHASE(9) {
        for (int blk = c; blk < T / 64; blk += G) {
            const int t0 = blk * 64;
            LAS int* li = (LAS int*)lds; LAS int* cnt = li; LAS int* wgoff = li + 32; LAS int* base = li + 64; LAS int* lcnt = li + 96; LAS int* tpl = li + 128; LAS int* sl = li + 192;
            if (tid < 32) { int total = 0, off = 0; for (int w8 = 0; w8 < T / 64; ++w8) { const int hv = HIST[w8 * 32 + tid]; total += hv; off += (w8 < blk) ? hv : 0; } cnt[tid] = total; wgoff[tid] = off; lcnt[tid] = 0; }
            __syncthreads();
            if (tid == 0) { int a = 0; for (int e = 0; e < 32; ++e) { tpl[e] = a; base[e] = a * 256; a += (cnt[e] + 255) >> 8; } tpl[32] = a; }
            __syncthreads();
            if (blk == 0 && tid < 33) TPREF[tid] = tpl[tid];
            if (tid < 128) { const int tok = t0 + (tid >> 1), k = tid & 1; const int e = TOKE[tok * 2 + k]; const int rank = atomicAdd((int*)&lcnt[e], 1); const int slot = base[e] + wgoff[e] + rank;
                TOKS[tok * 2 + k] = slot; SGATE[slot] = TOKG[tok * 2 + k]; sl[tid] = slot; }
            __syncthreads();
            for (int r = 0; r < 8; ++r) { const int tl = wave * 8 + r, tok = t0 + tl; const int s0 = sl[tl * 2], s1 = sl[tl * 2 + 1]; const float rstd = RSTD3[tok];
#pragma unroll
                for (int j = 0; j < 4; ++j) { const int col = (lane + 64 * j) * 4; const f32x4 v = *(const f32x4*)(OUT + (size_t)tok * 1024 + col), gn = *(const f32x4*)(args.in[24] + col);
                    u32x2 o; o.x = pk2(v[0] * rstd * gn[0], v[1] * rstd * gn[1]); o.y = pk2(v[2] * rstd * gn[2], v[3] * rstd * gn[3]);
                    *(u32x2*)(XG + (size_t)s0 * 1024 + col) = o; *(u32x2*)(XG + (size_t)s1 * 1024 + col) = o; } }
            __syncthreads();
        }
        if (BOTH(9)) GRID_BAR();
    }

    PHASE(10) {
        volatile LAS int* tp = (volatile LAS int*)(lds + EXT_OFF + 8192);
        if (tid < 33) tp[tid] = TPREF[tid];
        __syncthreads();
        { Gemm g{XG, WUP_T, 1024, 1024, 1024}; SchedMoe S; S.tp = tp; S.G = G; S.c = c; S.atile = 256ll * 1024 * 2; S.bexp = 1024ll * 1024 * 2; S.btile = 256ll * 1024 * 2;
          EpiPair<1> E{HID, 512, 0}; pg8::gemm_phase<EpiPair<1>, SchedMoe, true, true>(lds, g, S, E); }
        if (BOTH(10)) GRID_BAR();
    }

    PHASE(11) {
        volatile LAS int* tp = (volatile LAS int*)(lds + EXT_OFF + 8192);
        if (tid < 33) tp[tid] = TPREF[tid];
        __syncthreads();
        { Gemm g{HID, WDN_T, 512, 512, 512}; SchedMoe S; S.tp = tp; S.G = G; S.c = c; S.atile = 256ll * 512 * 2; S.bexp = 1024ll * 512 * 2; S.btile = 256ll * 512 * 2;
          EpiDown E{XG, SGATE}; pg8::gemm_phase<EpiDown, SchedMoe, true, true>(lds, g, S, E); }
        if (BOTH(11)) GRID_BAR();
    }

    PHASE(12) {
        for (int tok = gw; tok < T; tok += NGW) { const int s0 = TOKS[tok * 2], s1 = TOKS[tok * 2 + 1]; f32x4 v[4]; float ss = 0.f;
#pragma unroll
            for (int j = 0; j < 4; ++j) { const int col = (lane + 64 * j) * 4; v[j] = *(const f32x4*)(OUT + (size_t)tok * 1024 + col);
                const u32x2 a = *(const u32x2*)(XG + (size_t)s0 * 1024 + col), b2 = *(const u32x2*)(XG + (size_t)s1 * 1024 + col);
                v[j][0] += bflo(a.x) + bflo(b2.x); v[j][1] += bfhi(a.x) + bfhi(b2.x); v[j][2] += bflo(a.y) + bflo(b2.y); v[j][3] += bfhi(a.y) + bfhi(b2.y);
                ss += (v[j][0] * v[j][0] + v[j][1] * v[j][1]) + (v[j][2] * v[j][2] + v[j][3] * v[j][3]); }
            const float r = 1.0f / sqrtf(wave_sum(ss) * (1.f / D) + EPS);
#pragma unroll
            for (int j = 0; j < 4; ++j) { const int col = (lane + 64 * j) * 4; const f32x4 gn = *(const f32x4*)(args.in[32] + col); *(f32x4*)(OUT + (size_t)tok * 1024 + col) = v[j] * r * gn; } }
    }
#undef IN
#undef BOTH
#undef GRID_BAR
}

#ifndef PROBE_K
#define PROBE_K -1
#endif
extern "C" void kernel_launch(void* const* d_in, const int* in_sizes, int n_in, void* d_out, int out_size, void* d_ws, size_t ws_size, hipStream_t stream) {
    static int grid = 0;
    if (grid == 0) {
        if (n_in != 33 || in_sizes[0] != T * D || out_size != T * D || ws_size < WS_END) { fprintf(stderr, "kernel_launch: unexpected shapes (n_in %d, in0 %d, out %d, ws %zu); nothing launched\n", n_in, n_in > 0 ? in_sizes[0] : -1, out_size, ws_size); grid = -1; return; }
        int dev = 0, cus = 0, per_cu = 0;
        if (hipGetDevice(&dev) != hipSuccess || hipDeviceGetAttribute(&cus, hipDeviceAttributeMultiprocessorCount, dev) != hipSuccess) { grid = -1; return; }
        if (hipFuncSetAttribute((const void*)mk_fwd, hipFuncAttributeMaxDynamicSharedMemorySize, LDS_BYTES) != hipSuccess) { fprintf(stderr, "kernel_launch: hipFuncSetAttribute failed\n"); grid = -1; return; }
        if (hipOccupancyMaxActiveBlocksPerMultiprocessor(&per_cu, (const void*)mk_fwd, NTHR, LDS_BYTES) != hipSuccess || per_cu < 1) fprintf(stderr, "kernel_launch: note: occupancy query reports %d\n", per_cu);
        (void)hipGetLastError();
        grid = cus;
        if (grid != 256) { fprintf(stderr, "kernel_launch: built for a 256-CU device, got %d CUs; nothing launched\n", grid); grid = -1; return; }
    }
    if (grid < 0) return;
    if (hipMemsetAsync((char*)d_ws + WS_CTL, 0, CTL_ZERO_BYTES, stream) != hipSuccess) return;
    Args a{};
    for (int i = 0; i < 33; ++i) a.in[i] = (const float*)d_in[i];
    a.out = (float*)d_out; a.ws = (unsigned char*)d_ws;
#if MK_PER_PHASE
    for (int ph = 0; ph < NPHASE; ++ph) { a.ph_lo = ph; a.ph_hi = ph + 1; hipLaunchKernelGGL(mk_fwd, dim3(grid), dim3(NTHR), LDS_BYTES, stream, a); }
#else
#if PROBE_K >= 0
    a.ph_lo = 0; a.ph_hi = PROBE_K + 1; hipLaunchKernelGGL(mk_fwd, dim3(grid), dim3(NTHR), LDS_BYTES, stream, a);
    (void)hipMemsetAsync((char*)d_ws + WS_CTL, 0, CTL_ZERO_BYTES, stream);
    a.ph_lo = PROBE_K; a.ph_hi = NPHASE; hipLaunchKernelGGL(mk_fwd, dim3(grid), dim3(NTHR), LDS_BYTES, stream, a);
#else
    a.ph_lo = 0; a.ph_hi = NPHASE; hipLaunchKernelGGL(mk_fwd, dim3(grid), dim3(NTHR), LDS_BYTES, stream, a);
#endif
#endif
}
```

```cpp
#include <hip/hip_runtime.h>
#include <cstdio>
#include <cstdint>

#define LAS __attribute__((address_space(3)))
#define GAS __attribute__((address_space(1)))
#define CAS __attribute__((address_space(4)))
typedef unsigned short bf16;
typedef short bf16x8 __attribute__((ext_vector_type(8)));
typedef float f32x4 __attribute__((ext_vector_type(4)));
typedef float f32x2 __attribute__((ext_vector_type(2)));
typedef unsigned u32x4 __attribute__((ext_vector_type(4)));
typedef unsigned u32x2 __attribute__((ext_vector_type(2)));

#ifndef MK_PER_PHASE
#define MK_PER_PHASE 0
#endif

constexpr int NB = 2, SEQ = 8192, D = 1024, T = NB * SEQ, MEML = 256, TM = NB * MEML;
constexpr int DCONV = 512, CWID = 31, NG = 32, SGC = 16, NP = 64, NH = 4, HD = 256, NE = 32, EPG = 8, NGRP = 4, DE = 512;
constexpr int CH = 32, NCH = SEQ / CH, KE = CH * SGC, KY = KE + 2 * NP;
constexpr int CAP = 40960;
constexpr int NCOLR = 36;
constexpr float EPS = 1e-6f;
constexpr int NWAVES = 8, NTHR = 512, NPHASE = 13;

constexpr size_t MiB = 1u << 20, KiB = 1024;
constexpr size_t WS_CTL = 0, CTL_ZERO_BYTES = 32 * KiB;
constexpr int CW_BAR = 1024;
constexpr size_t WS_HIST = 1 * MiB, WS_TPREF = WS_HIST + 32 * KiB, WS_TOKE = WS_HIST + 64 * KiB, WS_TOKG = WS_HIST + 192 * KiB, WS_TOKS = WS_HIST + 320 * KiB,
                 WS_RSTD3 = WS_HIST + 448 * KiB, WS_SGATE = WS_HIST + 512 * KiB, WS_W36 = WS_HIST + 768 * KiB;
constexpr size_t WS_RS1 = 2 * MiB, WS_KMAT = 3 * MiB;
constexpr size_t WS_WIN = 8 * MiB, WS_WOUT = 11 * MiB, WS_WQ = 13 * MiB, WS_WKV = 15 * MiB, WS_WO = 19 * MiB, WS_TOEP = 21 * MiB, WS_ETAB = 41 * MiB, WS_GLUBT = 46 * MiB,
                 WS_MEMN = 47 * MiB, WS_KPROJ = 48 * MiB, WS_VT = 49 * MiB;
constexpr size_t WS_WUP = 50 * MiB, WS_WDN = 114 * MiB;
constexpr size_t WS_ACT = 146 * MiB;
constexpr size_t WS_HN = WS_ACT, WS_VBUF = WS_ACT + 32 * MiB, WS_UG = WS_ACT + 48 * MiB, WS_CONCAT = WS_ACT + 68 * MiB, WS_G = WS_ACT + 100 * MiB;
constexpr size_t WS_H1B = WS_ACT, WS_QBUF = WS_ACT + 32 * MiB, WS_PBUF = WS_ACT + 68 * MiB, WS_OBUF = WS_ACT + 100 * MiB;
constexpr size_t WS_XG = WS_ACT, WS_HID = WS_ACT + 80 * MiB;
constexpr size_t WS_END = 280 * MiB;
static_assert(WS_G + (size_t)T * 512 * 2 <= WS_END && WS_OBUF + (size_t)T * D * 2 <= WS_END && WS_HID + (size_t)CAP * DE * 2 <= WS_END && WS_UG + (size_t)NG * NB * NCH * KY * 2 <= WS_CONCAT, "d_ws map");

constexpr int RING_BYTES = 131072, EXT_OFF = RING_BYTES, EXT_BYTES = 16384, LCTL_OFF = EXT_OFF + EXT_BYTES, LDS_BYTES = LCTL_OFF + 512;

#define LDS_WAIT() asm volatile("s_waitcnt lgkmcnt(0)" ::: "memory")
#define VM_WAIT() asm volatile("s_waitcnt vmcnt(0)" ::: "memory")
__device__ __forceinline__ unsigned f2bf(float f) { unsigned u = __builtin_bit_cast(unsigned, f); return (u + 0x7fffu + ((u >> 16) & 1u)) >> 16; }
__device__ __forceinline__ unsigned pk2(float lo, float hi) { return f2bf(lo) | (f2bf(hi) << 16); }
__device__ __forceinline__ float bf2f(unsigned h) { return __builtin_bit_cast(float, h << 16); }
__device__ __forceinline__ float bflo(unsigned w) { return __builtin_bit_cast(float, w << 16); }
__device__ __forceinline__ float bfhi(unsigned w) { return __builtin_bit_cast(float, w & 0xffff0000u); }
__device__ __forceinline__ unsigned cvt_pk_bf16(float lo, float hi) { unsigned r; asm volatile("v_cvt_pk_bf16_f32 %0, %1, %2" : "=v"(r) : "v"(lo), "v"(hi)); return r; }
__device__ __forceinline__ u32x4 pack8(const f32x4 a, const f32x4 b) { u32x4 w; w.x = cvt_pk_bf16(a[0], a[1]); w.y = cvt_pk_bf16(a[2], a[3]); w.z = cvt_pk_bf16(b[0], b[1]); w.w = cvt_pk_bf16(b[2], b[3]); return w; }
__device__ __forceinline__ float sigmoidf_(float x) { return __builtin_amdgcn_rcpf(1.0f + __expf(-x)); }
__device__ __forceinline__ f32x4 sig4(f32x4 x) { f32x4 r; r[0] = sigmoidf_(x[0]); r[1] = sigmoidf_(x[1]); r[2] = sigmoidf_(x[2]); r[3] = sigmoidf_(x[3]); return r; }
__device__ __forceinline__ float gelu_tanh(float x) { const float z = 0.7978845608028654f * (x + 0.044715f * x * x * x); const float th = 1.0f - 2.0f * __builtin_amdgcn_rcpf(1.0f + __expf(2.0f * z)); return 0.5f * x * (1.0f + th); }
__device__ __forceinline__ int lane_id() { return (int)__builtin_amdgcn_mbcnt_hi(~0u, __builtin_amdgcn_mbcnt_lo(~0u, 0u)); }
__device__ __forceinline__ float wave_sum(float v) {
#pragma unroll
    for (int o = 1; o < 64; o <<= 1) v += __shfl_xor(v, o);
    return v;
}

namespace pg8 {
#define PG8_LAS __attribute__((address_space(3)))
typedef unsigned short bf16_t;
constexpr int BM = 256, BK = 64, HALF = 128, HTB = HALF * BK * 2  , STAGE_BYTES = 8 * HTB, NXCD = 8, WGM = 8;
__host__ __device__ __forceinline__ int lds_byte(int r, int c) { const int st = (r >> 4) * 2 + (c >> 5), rr = r & 15, cc = c & 31, ob = rr * 64 + cc * 2; return st * 1024 + (ob ^ (((ob >> 9) & 1) << 5)); }
__host__ __device__ __forceinline__ void stage_rc(int b, int& R, int& C) { const int st = b / 1024, sb = b % 1024, swz = sb ^ (((sb >> 9) & 1) << 5); R = (st >> 1) * 16 + swz / 64; C = (st & 1) * 32 + (swz % 64) / 2; }
__host__ __device__ __forceinline__ int perm32(int rho) { const int n = rho >> 4, i = rho & 15; return 8 * (i >> 2) + 4 * n + (i & 3); }

struct Unit { int pm, pn; long long aoff, boff; };
struct Gemm { const bf16_t* A; const bf16_t* Bt; int lda, ldb, K; };

__device__ __forceinline__ void static_unit(int L, int nM, int nN, int& pm, int& pn) {
    const int nwg = nM * nN; int wgid = L; { const int q = nwg / NXCD, r = nwg % NXCD, xcd = wgid % NXCD, off = wgid / NXCD; wgid = (xcd < r ? xcd * (q + 1) : r * (q + 1) + (xcd - r) * q) + off; }
    const int nig = WGM * nN, gid = wgid / nig, fm = gid * WGM, gsz = (nM - fm) < WGM ? (nM - fm) : WGM;
    pm = fm + ((wgid % nig) % gsz); pn = (wgid % nig) / gsz;
}
template <class Epi, class Sched, bool ALIGN_EPI = false, bool SP2 = false>
__device__ __forceinline__ void gemm_phase(PG8_LAS unsigned char* lds, const Gemm g, const Sched& S, const Epi& E, const int wave_id) {
    int lane_ = lane_id(); asm volatile("" : "+v"(lane_));
    const int wid = wave_id, lane = lane_, tid = wid * 64 + lane, wr = wid >> 2, wc = wid & 3, fr = lane & 15, fq = lane >> 4;
    const int K = g.K, nt = K / BK;
    unsigned voffA[2], voffB[2];
#pragma unroll
    for (int i = 0; i < 2; ++i) { int R, C; stage_rc(tid * 16 + i * 8192, R, C); const int Rb = Epi::PERM ? ((R & ~31) + perm32(R & 31)) : R;
        voffA[i] = (unsigned)(R * g.lda + C) * 2u; voffB[i] = (unsigned)(Rb * g.ldb + C) * 2u; }
    const size_t kstep = (size_t)(BK * 2);
    const size_t hstepA = (size_t)HALF * g.lda * 2, hstepB = (size_t)HALF * g.ldb * 2;
    const unsigned ldsw = (unsigned)wid * 1024u;
    const int aoff = lds_byte(wr * 64 + fr, fq * 8), boff = lds_byte(wc * 32 + fr, fq * 8);
#define PG8_SA(b, h) (((b) * 2 + (h)) * HTB)
#define PG8_SB(b, h) ((4 + (b) * 2 + (h)) * HTB)
#define PG8_STAGE(bufoff, gbase, voff) do { _Pragma("unroll") for (int _i = 0; _i < 2; ++_i) \
        __builtin_amdgcn_global_load_lds((const unsigned*)((const char*)(gbase) + (voff)[_i]), (PG8_LAS unsigned*)(lds + (bufoff) + ldsw + _i * 8192), 16, 0, 0); } while (0)
#define PG8_LDA(dst, b, h) do { _Pragma("unroll") for (int m = 0; m < 4; ++m) _Pragma("unroll") for (int k = 0; k < 2; ++k) dst[m][k] = *(const PG8_LAS bf16x8*)(lds + PG8_SA(b, h) + aoff + m * 2048 + k * 1024); } while (0)
#define PG8_LDB(dst, b, h) do { _Pragma("unroll") for (int n = 0; n < 2; ++n) _Pragma("unroll") for (int k = 0; k < 2; ++k) dst[n][k] = *(const PG8_LAS bf16x8*)(lds + PG8_SB(b, h) + boff + n * 2048 + k * 1024); } while (0)
#define PG8_MMA(ai, bj, At, Bt) do { __builtin_amdgcn_s_setprio(1); _Pragma("unroll") for (int m = 0; m < 4; ++m) _Pragma("unroll") for (int n = 0; n < 2; ++n) _Pragma("unroll") for (int k = 0; k < 2; ++k) \
        acc[ai][bj][m][n] = __builtin_amdgcn_mfma_f32_16x16x32_bf16(Bt[n][k], At[m][k], acc[ai][bj][m][n], 0, 0, 0); __builtin_amdgcn_s_setprio(0); } while (0)
#define PG8_WAIT_V(n) asm volatile("s_waitcnt vmcnt(" #n ")" ::: "memory")
#define PG8_WAIT_L(n) asm volatile("s_waitcnt lgkmcnt(" #n ")" ::: "memory")
#define PG8_BAR __builtin_amdgcn_s_barrier()
#define PG8_SCHED __builtin_amdgcn_sched_barrier(0)
    Unit cur, nxt; int ui = 0;
    if (!S.next(0, cur)) return;
    f32x4 acc[2][2][4][2];
#pragma unroll
    for (int a = 0; a < 2; ++a)
#pragma unroll
        for (int b = 0; b < 2; ++b)
#pragma unroll
            for (int m = 0; m < 4; ++m)
#pragma unroll
                for (int n = 0; n < 2; ++n) acc[a][b][m][n] = (f32x4){0.f, 0.f, 0.f, 0.f};
    bf16x8 At[4][2], B0[2][2], B1[2][2];
    const char* cA = (const char*)g.A + cur.aoff; const char* cB = (const char*)g.Bt + cur.boff;
    S.a_ready(cur);
    if constexpr (SP2) {
        PG8_STAGE(PG8_SB(0, 0), cB, voffB); PG8_STAGE(PG8_SB(0, 1), cB + hstepB, voffB); PG8_STAGE(PG8_SA(0, 0), cA, voffA); PG8_STAGE(PG8_SA(0, 1), cA + hstepA, voffA);
        if (wr == 1) PG8_BAR;
        PG8_WAIT_V(2); PG8_BAR;
        PG8_STAGE(PG8_SB(1, 0), cB + kstep, voffB); PG8_STAGE(PG8_SA(1, 0), cA + kstep, voffA); PG8_STAGE(PG8_SB(1, 1), cB + hstepB + kstep, voffB);
        PG8_WAIT_V(6); PG8_BAR;
    } else {
        PG8_STAGE(PG8_SB(0, 0), cB, voffB); PG8_STAGE(PG8_SA(0, 0), cA, voffA); PG8_STAGE(PG8_SB(0, 1), cB + hstepB, voffB); PG8_STAGE(PG8_SA(0, 1), cA + hstepA, voffA);
        if (wr == 1) PG8_BAR;
        PG8_WAIT_V(4); PG8_BAR;
        PG8_STAGE(PG8_SB(1, 0), cB + kstep, voffB); PG8_STAGE(PG8_SA(1, 0), cA + kstep, voffA); PG8_STAGE(PG8_SB(1, 1), cB + hstepB + kstep, voffB);
        PG8_WAIT_V(6); PG8_BAR;
    }
    for (;;) {
        const bool has_next = S.next(ui + 1, nxt);
        const char* nA = has_next ? (const char*)g.A + nxt.aoff : cA; const char* nB = has_next ? (const char*)g.Bt + nxt.boff : cB;
#pragma unroll 1
        for (int t = 0; t < nt; t += 2) {
            const bool last = (t == nt - 2);
            const char* a1 = cA + (size_t)(t + 1) * kstep;
            const char* a2 = last ? nA : cA + (size_t)(t + 2) * kstep; const char* b2 = last ? nB : cB + (size_t)(t + 2) * kstep;
            const char* a3 = a2 + kstep; const char* b3 = b2 + kstep;
            if (last && has_next) S.a_ready(nxt);
            if constexpr (SP2) {
            PG8_LDB(B0, 0, 0); PG8_LDB(B1, 0, 1); PG8_SCHED; PG8_LDA(At, 0, 0); PG8_STAGE(PG8_SA(1, 1), a1 + hstepA, voffA);
            PG8_WAIT_V(8); PG8_WAIT_L(0); PG8_BAR; PG8_MMA(0, 0, At, B0); PG8_MMA(0, 1, At, B1); PG8_BAR; PG8_SCHED;
            PG8_LDA(At, 0, 1); PG8_STAGE(PG8_SB(0, 0), b2, voffB); PG8_STAGE(PG8_SB(0, 1), b2 + hstepB, voffB); PG8_STAGE(PG8_SA(0, 0), a2, voffA);
            PG8_WAIT_V(8); PG8_WAIT_L(0); PG8_BAR; PG8_MMA(1, 0, At, B0); PG8_MMA(1, 1, At, B1); PG8_BAR; PG8_SCHED;
            PG8_LDB(B0, 1, 0); PG8_LDB(B1, 1, 1); PG8_SCHED; PG8_LDA(At, 1, 0); PG8_STAGE(PG8_SA(0, 1), a2 + hstepA, voffA);
            PG8_WAIT_V(8); PG8_WAIT_L(0); PG8_BAR; PG8_MMA(0, 0, At, B0); PG8_MMA(0, 1, At, B1); PG8_BAR; PG8_SCHED;
            PG8_LDA(At, 1, 1); PG8_STAGE(PG8_SB(1, 0), b3, voffB); PG8_STAGE(PG8_SB(1, 1), b3 + hstepB, voffB); PG8_STAGE(PG8_SA(1, 0), a3, voffA);
            PG8_WAIT_V(8); PG8_WAIT_L(0); PG8_BAR; PG8_MMA(1, 0, At, B0); PG8_MMA(1, 1, At, B1); PG8_BAR; PG8_SCHED;
            } else {
            PG8_LDB(B0, 0, 0); PG8_SCHED; PG8_LDA(At, 0, 0); PG8_STAGE(PG8_SA(1, 1), a1 + hstepA, voffA);
            PG8_WAIT_L(8); PG8_BAR; PG8_WAIT_L(0); PG8_MMA(0, 0, At, B0); PG8_BAR; PG8_SCHED;
            PG8_LDB(B1, 0, 1); PG8_STAGE(PG8_SB(0, 0), b2, voffB);
            PG8_BAR; PG8_WAIT_L(0); PG8_MMA(0, 1, At, B1); PG8_BAR;
            PG8_LDA(At, 0, 1); PG8_STAGE(PG8_SA(0, 0), a2, voffA);
            PG8_BAR; PG8_WAIT_L(0); PG8_MMA(1, 0, At, B0); PG8_BAR; PG8_SCHED;
            PG8_STAGE(PG8_SB(0, 1), b2 + hstepB, voffB);
            PG8_WAIT_V(6); PG8_BAR; PG8_MMA(1, 1, At, B1); PG8_BAR;
            PG8_LDB(B0, 1, 0); PG8_SCHED; PG8_LDA(At, 1, 0); PG8_STAGE(PG8_SA(0, 1), a2 + hstepA, voffA);
            PG8_WAIT_L(8); PG8_BAR; PG8_WAIT_L(0); PG8_MMA(0, 0, At, B0); PG8_BAR; PG8_SCHED;
            PG8_LDB(B1, 1, 1); PG8_STAGE(PG8_SB(1, 0), b3, voffB);
            PG8_BAR; PG8_WAIT_L(0); PG8_MMA(0, 1, At, B1); PG8_BAR;
            PG8_LDA(At, 1, 1); PG8_STAGE(PG8_SA(1, 0), a3, voffA);
            PG8_BAR; PG8_WAIT_L(0); PG8_MMA(1, 0, At, B0); PG8_BAR; PG8_SCHED;
            PG8_STAGE(PG8_SB(1, 1), b3 + hstepB, voffB);
            PG8_WAIT_V(6); PG8_BAR; PG8_MMA(1, 1, At, B1); PG8_BAR;
            }
        }
        if constexpr (ALIGN_EPI) { if (wr == 0) PG8_BAR; }
        if constexpr (!Epi::AFTER_DRAIN) { E(acc, cur, wr, wc, fr, fq); S.done(cur); }
        if (!has_next) break;
#pragma unroll
        for (int a = 0; a < 2; ++a)
#pragma unroll
            for (int b = 0; b < 2; ++b)
#pragma unroll
                for (int m = 0; m < 4; ++m)
#pragma unroll
                    for (int n = 0; n < 2; ++n) acc[a][b][m][n] = (f32x4){0.f, 0.f, 0.f, 0.f};
        cur = nxt; cA = nA; cB = nB; ++ui;
        if constexpr (ALIGN_EPI) { if (wr == 1) PG8_BAR; }
    }
    PG8_WAIT_V(0);
    if constexpr (!ALIGN_EPI) { if (wr == 0) PG8_BAR; }
    PG8_BAR;
    if constexpr (Epi::AFTER_DRAIN) { E.fused(acc, cur, wr, wc, fr, fq, lds, wid, lane); S.done(cur); }
#undef PG8_SA
#undef PG8_SB
#undef PG8_STAGE
#undef PG8_LDA
#undef PG8_LDB
#undef PG8_MMA
#undef PG8_WAIT_V
#undef PG8_WAIT_L
#undef PG8_BAR
#undef PG8_SCHED
}

}

using pg8::Unit; using pg8::Gemm;
typedef f32x4 Acc[2][2][4][2];

struct SchedBase { __device__ __forceinline__ void a_ready(const Unit&) const {} __device__ __forceinline__ void done(const Unit&) const {} };
struct SchedGrid : SchedBase { int nM, nN, G, c; long long atile, btile, acol;
    __device__ __forceinline__ bool next(int i, Unit& u) const { const int L = i * G + c; if (L >= nM * nN) return false; pg8::static_unit(L, nM, nN, u.pm, u.pn);
        u.aoff = (long long)u.pm * atile + (long long)u.pn * acol; u.boff = (long long)u.pn * btile; return true; } };
struct SchedOne : SchedBase { Unit u0; bool have;
    __device__ __forceinline__ bool next(int i, Unit& u) const { if (i != 0 || !have) return false; u = u0; return true; } };
struct SchedMoe : SchedBase { volatile LAS int* tp; int G, c; long long atile, bexp, btile;
    __device__ __forceinline__ bool next(int i, Unit& u) const { const int L = i * G + c; const int nt4 = tp[32] * 4; if (L >= nt4) return false; const int tile = L >> 2; u.pm = tile; u.pn = L & 3;
        int e = 0;
#pragma unroll 1
        for (int k = 1; k < 32; ++k) e += (tp[k] <= tile) ? 1 : 0;
        u.aoff = (long long)tile * atile; u.boff = (long long)e * bexp + (long long)u.pn * btile; return true; } };

#define EPI_COMMON static constexpr bool PERM = true, AFTER_DRAIN = false;
struct EpiIn { EPI_COMMON bf16* V; bf16* UG;
    __device__ __forceinline__ void operator()(const Acc& acc, const Unit& u, int wr, int wc, int fr, int fq) const {
        const int row0 = u.pm * 256 + wr * 64 + fr;
        if (u.pn < 4) {
#pragma unroll
            for (int ai = 0; ai < 2; ++ai)
#pragma unroll
                for (int m = 0; m < 4; ++m) { const int row = row0 + ai * 128 + m * 16;
                    const f32x4 v0 = acc[ai][0][m][0] * sig4(acc[ai][1][m][0]), v1 = acc[ai][0][m][1] * sig4(acc[ai][1][m][1]);
                    *(u32x4*)(V + (size_t)row * 512 + u.pn * 128 + wc * 32 + 8 * fq) = pack8(v0, v1); }
        } else {
#pragma unroll
            for (int ai = 0; ai < 2; ++ai)
#pragma unroll
                for (int m = 0; m < 4; ++m) { const int row = row0 + ai * 128 + m * 16; const int b = row >> 13, chunk = (row >> 5) & 255, j = row & 31;
#pragma unroll
                    for (int bj = 0; bj < 2; ++bj) { const int cu = (u.pn - 4) * 256 + bj * 128 + wc * 32 + 8 * fq; const int g = cu >> 4, c0 = cu & 15;
                        *(u32x4*)(UG + ((size_t)((g * 2 + b) * 256 + chunk)) * KY + j * 16 + c0) = pack8(acc[ai][bj][m][0], acc[ai][bj][m][1]); } }
        }
    } };
struct EpiKV { EPI_COMMON bf16* KP; bf16* VT;
    __device__ __forceinline__ void operator()(const Acc& acc, const Unit& u, int wr, int wc, int fr, int fq) const {
        const int row0 = u.pm * 256 + wr * 64 + fr;
#pragma unroll
        for (int ai = 0; ai < 2; ++ai)
#pragma unroll
            for (int m = 0; m < 4; ++m) { const int row = row0 + ai * 128 + m * 16;
#pragma unroll
                for (int bj = 0; bj < 2; ++bj) { const int col = bj * 128 + wc * 32 + 8 * fq;
                    if (u.pn < 4) *(u32x4*)(KP + (size_t)row * 1024 + u.pn * 256 + col) = pack8(acc[ai][bj][m][0], acc[ai][bj][m][1]);
                    else { const int b = row >> 8, key = row & 255, h = u.pn - 4; bf16* vt = VT + ((size_t)(b * 4 + h) * 256 + col) * 256 + key;
#pragma unroll
                        for (int n = 0; n < 2; ++n)
#pragma unroll
                            for (int e = 0; e < 4; ++e) vt[(n * 4 + e) * 256] = (bf16)f2bf(acc[ai][bj][m][n][e]); } } }
    } };
struct EpiScan { static constexpr bool PERM = true, AFTER_DRAIN = true; bf16* UG; const float* Are; const float* Aim; const float* logdt;
    __device__ __forceinline__ void fused(const Acc& acc, const Unit& u, int wr, int wc, int fr, int fq, LAS unsigned char* lds, int wid, int lane) const {
        LAS float* El = (LAS float*)lds;
#pragma unroll
        for (int ai = 0; ai < 2; ++ai)
#pragma unroll
            for (int m = 0; m < 4; ++m) { const int row = ai * 128 + wr * 64 + m * 16 + fr;
#pragma unroll
                for (int n = 0; n < 2; ++n) { const int cc = (wc * 32 + 8 * fq + 4 * n) >> 2; *(LAS f32x4*)(El + row * 128 + ((cc ^ (row & 31)) << 2)) = acc[ai][0][m][n]; } }
        __syncthreads();
        if (wid == 0) {
            const int g = u.pm >> 1, p = lane;
            const double dt = exp((double)logdt[g]); const double lr = (double)Are[g * NP + p] * dt * CH, li = (double)Aim[g * NP + p] * dt * CH;
            const double mag = exp(lr); double sn, cs; sincos(li, &sn, &cs);
            const float ar = (float)(mag * cs), aim = (float)(mag * sn);
            float sr = 0.f, si = 0.f;
            bf16* ug = UG + (size_t)u.pm * 256 * KY + KE;
#pragma unroll 4
            for (int ch = 0; ch < NCH; ++ch) {
                ug[(size_t)ch * KY + p] = (bf16)f2bf(sr); ug[(size_t)ch * KY + NP + p] = (bf16)f2bf(si);
                const int sw = ch & 31; const float er = El[ch * 128 + ((((p >> 2) ^ sw) << 2) | (p & 3))], ei = El[ch * 128 + (((((64 + p) >> 2) ^ sw) << 2) | (p & 3))];
                const float nr = ar * sr - aim * si + er, ni = ar * si + aim * sr + ei; sr = nr; si = ni;
            }
        }
    } };
struct EpiY { EPI_COMMON const bf16* UG; const float* Dv; bf16* Gb;
    __device__ __forceinline__ void operator()(const Acc& acc, const Unit& u, int wr, int wc, int fr, int fq) const {
        const int g = u.pm >> 1, b = u.pm & 1, i = u.pn * 16 + 4 * wc + fq;
        f32x4 dv[4];
#pragma unroll
        for (int k = 0; k < 4; ++k) dv[k] = *(const f32x4*)(Dv + g * 16 + 4 * k);
#pragma unroll
        for (int ai = 0; ai < 2; ++ai)
#pragma unroll
            for (int m = 0; m < 4; ++m) { const int chunk = ai * 128 + wr * 64 + m * 16 + fr;
                const u32x4* up = (const u32x4*)(UG + ((size_t)u.pm * 256 + chunk) * KY + i * 16);
                const size_t t = (size_t)b * SEQ + chunk * CH + i;
#pragma unroll
                for (int bj = 0; bj < 2; ++bj) { const u32x4 uw = up[bj]; f32x4 y0 = acc[ai][bj][m][0], y1 = acc[ai][bj][m][1];
                    y0[0] += dv[2 * bj][0] * bflo(uw.x); y0[1] += dv[2 * bj][1] * bfhi(uw.x); y0[2] += dv[2 * bj][2] * bflo(uw.y); y0[3] += dv[2 * bj][3] * bfhi(uw.y);
                    y1[0] += dv[2 * bj + 1][0] * bflo(uw.z); y1[1] += dv[2 * bj + 1][1] * bfhi(uw.z); y1[2] += dv[2 * bj + 1][2] * bflo(uw.w); y1[3] += dv[2 * bj + 1][3] * bfhi(uw.w);
#pragma unroll
                    for (int e = 0; e < 4; ++e) { y0[e] = gelu_tanh(y0[e]); y1[e] = gelu_tanh(y1[e]); }
                    *(u32x4*)(Gb + t * 512 + g * 16 + bj * 8) = pack8(y0, y1); } }
    } };
template <int MODE> struct EpiPair { EPI_COMMON bf16* O; int ld, coloff;
    __device__ __forceinline__ void operator()(const Acc& acc, const Unit& u, int wr, int wc, int fr, int fq) const {
        const int row0 = u.pm * 256 + wr * 64 + fr;
#pragma unroll
        for (int ai = 0; ai < 2; ++ai)
#pragma unroll
            for (int m = 0; m < 4; ++m) { const int row = row0 + ai * 128 + m * 16; f32x4 v0, v1;
                if (MODE == 0) { v0 = acc[ai][0][m][0] * sig4(acc[ai][1][m][0]); v1 = acc[ai][0][m][1] * sig4(acc[ai][1][m][1]); }
                else { v0 = acc[ai][0][m][0] * sig4(acc[ai][0][m][0]) * acc[ai][1][m][0]; v1 = acc[ai][0][m][1] * sig4(acc[ai][0][m][1]) * acc[ai][1][m][1]; }
                *(u32x4*)(O + (size_t)row * ld + coloff + u.pn * 128 + wc * 32 + 8 * fq) = pack8(v0, v1); }
    } };
struct EpiH1 { EPI_COMMON const float* X; float* OUT; bf16* H1B; float* RS1;
    __device__ __forceinline__ void operator()(const Acc& acc, const Unit& u, int wr, int wc, int fr, int fq) const {
        const int row0 = u.pm * 256 + wr * 64 + fr;
#pragma unroll
        for (int ai = 0; ai < 2; ++ai)
#pragma unroll
            for (int m = 0; m < 4; ++m) { const int row = row0 + ai * 128 + m * 16; float ss = 0.f;
#pragma unroll
                for (int bj = 0; bj < 2; ++bj) { const size_t o = (size_t)row * 1024 + u.pn * 256 + bj * 128 + wc * 32 + 8 * fq;
                    const f32x4 h0 = *(const f32x4*)(X + o) + acc[ai][bj][m][0], h1 = *(const f32x4*)(X + o + 4) + acc[ai][bj][m][1];
                    *(f32x4*)(OUT + o) = h0; *(f32x4*)(OUT + o + 4) = h1; *(u32x4*)(H1B + o) = pack8(h0, h1);
                    ss += (h0[0] * h0[0] + h0[1] * h0[1]) + (h0[2] * h0[2] + h0[3] * h0[3]) + (h1[0] * h1[0] + h1[1] * h1[1]) + (h1[2] * h1[2] + h1[3] * h1[3]); }
                ss += __shfl_xor(ss, 16); ss += __shfl_xor(ss, 32);
                if (fq == 0) RS1[(size_t)row * 16 + u.pn * 4 + wc] = ss; }
    } };
struct EpiQ { EPI_COMMON bf16* Q; const LAS float* rl;
    __device__ __forceinline__ void operator()(const Acc& acc, const Unit& u, int wr, int wc, int fr, int fq) const {
#pragma unroll
        for (int ai = 0; ai < 2; ++ai)
#pragma unroll
            for (int m = 0; m < 4; ++m) { const int rloc = ai * 128 + wr * 64 + m * 16 + fr; const float s = rl[rloc] * 0.0625f; const size_t row = (size_t)u.pm * 256 + rloc;
#pragma unroll
                for (int bj = 0; bj < 2; ++bj) *(u32x4*)(Q + row * 1024 + u.pn * 256 + bj * 128 + wc * 32 + 8 * fq) = pack8(acc[ai][bj][m][0] * s, acc[ai][bj][m][1] * s); }
    } };
struct EpiSm { static constexpr bool PERM = true, AFTER_DRAIN = true; bf16* P;
    __device__ __forceinline__ void fused(Acc& acc, const Unit& u, int wr, int wc, int fr, int fq, LAS unsigned char* lds, int wid, int lane) const {
        LAS float* Xm = (LAS float*)lds; LAS float* Xs = Xm + 1024;
#pragma unroll
        for (int ai = 0; ai < 2; ++ai)
#pragma unroll
            for (int m = 0; m < 4; ++m) { float v = -3.0e38f;
#pragma unroll
                for (int bj = 0; bj < 2; ++bj)
#pragma unroll
                    for (int n = 0; n < 2; ++n)
#pragma unroll
                        for (int e = 0; e < 4; ++e) v = fmaxf(v, acc[ai][bj][m][n][e]);
                v = fmaxf(v, __shfl_xor(v, 16)); v = fmaxf(v, __shfl_xor(v, 32));
                if (fq == 0) Xm[(ai * 128 + wr * 64 + m * 16 + fr) * 4 + wc] = v; }
        __syncthreads();
#pragma unroll
        for (int ai = 0; ai < 2; ++ai)
#pragma unroll
            for (int m = 0; m < 4; ++m) { const f32x4 q = *(const LAS f32x4*)(Xm + (ai * 128 + wr * 64 + m * 16 + fr) * 4); const float rm = fmaxf(fmaxf(q[0], q[1]), fmaxf(q[2], q[3])); float s = 0.f;
#pragma unroll
                for (int bj = 0; bj < 2; ++bj)
#pragma unroll
                    for (int n = 0; n < 2; ++n)
#pragma unroll
                        for (int e = 0; e < 4; ++e) { const float pe = __expf(acc[ai][bj][m][n][e] - rm); acc[ai][bj][m][n][e] = pe; s += pe; }
                s += __shfl_xor(s, 16); s += __shfl_xor(s, 32);
                if (fq == 0) Xs[(ai * 128 + wr * 64 + m * 16 + fr) * 4 + wc] = s; }
        __syncthreads();
#pragma unroll
        for (int ai = 0; ai < 2; ++ai)
#pragma unroll
            for (int m = 0; m < 4; ++m) { const int rloc = ai * 128 + wr * 64 + m * 16 + fr; const f32x4 q = *(const LAS f32x4*)(Xs + rloc * 4); const float inv = __builtin_amdgcn_rcpf((q[0] + q[1]) + (q[2] + q[3]));
                const size_t row = (size_t)u.pm * 256 + rloc;
#pragma unroll
                for (int bj = 0; bj < 2; ++bj) *(u32x4*)(P + row * 1024 + u.pn * 256 + bj * 128 + wc * 32 + 8 * fq) = pack8(acc[ai][bj][m][0] * inv, acc[ai][bj][m][1] * inv); }
    } };
struct EpiBf { EPI_COMMON bf16* O; int ld;
    __device__ __forceinline__ void operator()(const Acc& acc, const Unit& u, int wr, int wc, int fr, int fq) const {
        const int row0 = u.pm * 256 + wr * 64 + fr;
#pragma unroll
        for (int ai = 0; ai < 2; ++ai)
#pragma unroll
            for (int m = 0; m < 4; ++m) { const int row = row0 + ai * 128 + m * 16;
#pragma unroll
                for (int bj = 0; bj < 2; ++bj) *(u32x4*)(O + (size_t)row * ld + u.pn * 256 + bj * 128 + wc * 32 + 8 * fq) = pack8(acc[ai][bj][m][0], acc[ai][bj][m][1]); }
    } };
struct EpiH2 { EPI_COMMON float* OUT;
    __device__ __forceinline__ void operator()(const Acc& acc, const Unit& u, int wr, int wc, int fr, int fq) const {
        const int row0 = u.pm * 256 + wr * 64 + fr;
#pragma unroll
        for (int ai = 0; ai < 2; ++ai)
#pragma unroll
            for (int m = 0; m < 4; ++m) { const int row = row0 + ai * 128 + m * 16;
#pragma unroll
                for (int bj = 0; bj < 2; ++bj) { float* o = OUT + (size_t)row * 1024 + u.pn * 256 + bj * 128 + wc * 32 + 8 * fq;
                    const f32x4 h0 = *(const f32x4*)o + acc[ai][bj][m][0], h1 = *(const f32x4*)(o + 4) + acc[ai][bj][m][1]; *(f32x4*)o = h0; *(f32x4*)(o + 4) = h1; } }
    } };
struct EpiDown { EPI_COMMON bf16* Y; const float* gate;
    __device__ __forceinline__ void operator()(const Acc& acc, const Unit& u, int wr, int wc, int fr, int fq) const {
        const int row0 = u.pm * 256 + wr * 64 + fr;
#pragma unroll
        for (int ai = 0; ai < 2; ++ai)
#pragma unroll
            for (int m = 0; m < 4; ++m) { const int row = row0 + ai * 128 + m * 16; const float gt = gate[row];
#pragma unroll
                for (int bj = 0; bj < 2; ++bj) *(u32x4*)(Y + (size_t)row * 1024 + u.pn * 256 + bj * 128 + wc * 32 + 8 * fq) = pack8(acc[ai][bj][m][0] * gt, acc[ai][bj][m][1] * gt); }
    } };

#define XB_TMO      128
#define XB_XCNT(j)  (256  + 64 * (j))
#define XB_XSUB(j)  (1280 + 64 * (j))
#define XB_XGEN(j)  (2304 + 64 * (j))
#define XB_TOP      3328
#define XB_TOPGEN   3392
#define XCD_BAR_WORDS 3456
#define XB_SPIN_CAP (1u << 18)

__device__ __forceinline__ unsigned xb_ld(unsigned* p)              { return __hip_atomic_load(p, __ATOMIC_RELAXED, __HIP_MEMORY_SCOPE_AGENT); }
__device__ __forceinline__ unsigned xb_add(unsigned* p, unsigned v) { return __hip_atomic_fetch_add(p, v, __ATOMIC_RELAXED, __HIP_MEMORY_SCOPE_AGENT); }
__device__ __forceinline__ unsigned xb_xcc_id() { return (unsigned)__builtin_amdgcn_s_getreg((3 << 11) | 20) & 0xFu; }
#define XB_SPIN(cond, bar) do { unsigned _sp = 0; while (cond) { __builtin_amdgcn_s_sleep(1); \
    if ((++_sp & 255u) == 0u) { if (xb_ld(&(bar)[XB_TMO])) break; if (_sp > XB_SPIN_CAP) { atomicAdd(&(bar)[XB_TMO], 1u); break; } } } } while (0)

struct XcdBarrier {
    unsigned* bar; unsigned x;
    unsigned w0;
    volatile LAS unsigned* st;
};

__device__ __forceinline__ XcdBarrier xcd_barrier_post(unsigned* bar, volatile LAS unsigned* st) {
    XcdBarrier b; b.bar = bar; b.x = xb_xcc_id(); b.st = st; b.w0 = (__builtin_amdgcn_readfirstlane((int)threadIdx.x >> 6) == 0) ? 1u : 0u;
    if (threadIdx.x == 0) (void)xb_add(&bar[XB_XCNT(b.x)], 1u);
    return b;
}
__device__ __forceinline__ void xcd_barrier_complete(unsigned* bar, unsigned x, unsigned& nloc, unsigned& nx) {
    const unsigned G = gridDim.x * gridDim.y * gridDim.z;
    unsigned sum, cnt, mine, sp = 0u;
    for (;;) {
        sum = 0u; cnt = 0u; mine = 0u;
#pragma unroll
        for (unsigned j = 0; j < 16; ++j) { const unsigned c = xb_ld(&bar[XB_XCNT(j)]); sum += c; cnt += (c > 0u) ? 1u : 0u; mine = (j == x) ? c : mine; }
        if (sum == G) break;
        __builtin_amdgcn_s_sleep(1);
        if ((++sp & 255u) == 0u) { if (xb_ld(&bar[XB_TMO])) break; if (sp > XB_SPIN_CAP) { atomicAdd(&bar[XB_TMO], 1u); break; } }
    }
    nloc = mine > 0u ? mine : 1u; nx = cnt > 0u ? cnt : 1u;
}

__device__ __forceinline__ void xcd_barrier(const XcdBarrier& b) {
    asm volatile("s_waitcnt vmcnt(0)" ::: "memory");
    __syncthreads();
    if (b.w0 && lane_id() == 0) {
        unsigned* bar = b.bar;
        __builtin_amdgcn_s_waitcnt(0);
        unsigned nloc = b.st[0], nx = b.st[1];
        if (nloc == 0u) { xcd_barrier_complete(bar, b.x, nloc, nx); b.st[0] = nloc; b.st[1] = nx; }
        const unsigned old = xb_add(&bar[XB_XSUB(b.x)], 1u);
        const unsigned gen = old / nloc;
        if (old + 1u == (gen + 1u) * nloc) {
            __builtin_amdgcn_fence(__ATOMIC_RELEASE, "agent");
            asm volatile("s_waitcnt vmcnt(0)" ::: "memory");
            const unsigned og = xb_add(&bar[XB_TOP], 1u);
            const unsigned tg = og / nx;
            if (og + 1u == (tg + 1u) * nx) xb_add(&bar[XB_TOPGEN], 1u);
            else XB_SPIN(xb_ld(&bar[XB_TOPGEN]) == tg, bar);
            __builtin_amdgcn_fence(__ATOMIC_ACQUIRE, "agent");
            xb_add(&bar[XB_XGEN(b.x)], 1u);
            asm volatile("s_waitcnt vmcnt(0)" ::: "memory");
        } else {
            XB_SPIN(xb_ld(&bar[XB_XGEN(b.x)]) == gen, bar);
            __builtin_amdgcn_fence(__ATOMIC_ACQUIRE, "agent");
            asm volatile("s_waitcnt vmcnt(0)" ::: "memory");
        }
    }
    __syncthreads();
}

__device__ __forceinline__ void transpose_item(const float* W, int ldw, bf16* WT, int ldwt, int k0, int n0, int dst_row0, const float* kscale, LAS float* scr, int lane) {
#pragma unroll 8
    for (int i = 0; i < 32; ++i) { const int kk = 2 * i + (lane >> 5); float v = W[(size_t)(k0 + kk) * ldw + n0 + (lane & 31)]; if (kscale) v *= kscale[k0 + kk]; scr[kk * 33 + (lane & 31)] = v; }
    LDS_WAIT(); asm volatile("" ::: "memory");
    const int c = lane & 7;
#pragma unroll
    for (int j = 0; j < 4; ++j) { const int n = (lane >> 3) + 8 * j; const LAS float* s = scr + (8 * c) * 33 + n;
        u32x4 o; o.x = pk2(s[0 * 33], s[1 * 33]); o.y = pk2(s[2 * 33], s[3 * 33]); o.z = pk2(s[4 * 33], s[5 * 33]); o.w = pk2(s[6 * 33], s[7 * 33]);
        *(u32x4*)(WT + (size_t)(dst_row0 + n) * ldwt + k0 + 8 * c) = o; }
    LDS_WAIT(); asm volatile("" ::: "memory");
}
__device__ __forceinline__ void rms_row_to_bf16(const float* xrow, const float* gain, bf16* orow, int lane) {
    f32x4 v[4]; float s = 0.f;
#pragma unroll
    for (int j = 0; j < 4; ++j) { v[j] = *(const f32x4*)(xrow + (lane + 64 * j) * 4); s += (v[j][0] * v[j][0] + v[j][1] * v[j][1]) + (v[j][2] * v[j][2] + v[j][3] * v[j][3]); }
    const float r = 1.0f / sqrtf(wave_sum(s) * (1.f / D) + EPS);
#pragma unroll
    for (int j = 0; j < 4; ++j) { const f32x4 gn = *(const f32x4*)(gain + (lane + 64 * j) * 4); u32x2 o; o.x = pk2(v[j][0] * r * gn[0], v[j][1] * r * gn[1]); o.y = pk2(v[j][2] * r * gn[2], v[j][3] * r * gn[3]);
        *(u32x2*)(orow + (lane + 64 * j) * 4) = o; }
}
__device__ __forceinline__ void ssm_consts(const float* Are, const float* Aim, const float* logdt, int g, int p, double& lr, double& li, double& cr, double& ci) {
    const double dt = exp((double)logdt[g]), a = (double)Are[g * NP + p], b = (double)Aim[g * NP + p];
    lr = a * dt; li = b * dt;
    const double mag = exp(lr); double sn, cs; sincos(li, &sn, &cs);
    const double x = mag * cs - 1.0, y = mag * sn, den = a * a + b * b;
    cr = (x * a + y * b) / den; ci = (y * a - x * b) / den;
}
__device__ __forceinline__ void cpow_d(double lr, double li, int m, float& zr, float& zi) { const double mag = exp(lr * m); double sn, cs; sincos(li * m, &sn, &cs); zr = (float)(mag * cs); zi = (float)(mag * sn); }

struct Args { const float* in[33]; float* out; unsigned char* ws; int ph_lo, ph_hi; };

template <int NS> __device__ __forceinline__ void conv_block(float (&win)[CWID], const float (&w)[CWID], const bf16* vcol, float bias, LAS float* outl) {
#pragma unroll
    for (int ss = 0; ss < NS; ++ss) {
        win[ss % CWID] = bf2f(vcol[(size_t)ss * 512]);
        float a = bias;
#pragma unroll
        for (int k = 0; k < CWID; ++k) a += w[k] * win[(ss + k + 1) % CWID];
        outl[ss * 512] = a;
    }
}

__device__ __forceinline__ int toep_col(int i, int c) { return (i >> 4) * 256 + (c >> 3) * 128 + (i & 15) * 8 + (c & 7); }


#define X (args.in[0])
#define OUT (args.out)
#define WSP(T_, off) ((T_*)(ws + (off)))
#define WIN_T WSP(bf16, WS_WIN)
#define WOUT_T WSP(bf16, WS_WOUT)
#define WQ_T WSP(bf16, WS_WQ)
#define WKV_T WSP(bf16, WS_WKV)
#define WO_T WSP(bf16, WS_WO)
#define TOEP WSP(bf16, WS_TOEP)
#define ETAB WSP(bf16, WS_ETAB)
#define GLUBT WSP(bf16, WS_GLUBT)
#define MEMN WSP(bf16, WS_MEMN)
#define KPROJ WSP(bf16, WS_KPROJ)
#define VT WSP(bf16, WS_VT)
#define WUP_T WSP(bf16, WS_WUP)
#define WDN_T WSP(bf16, WS_WDN)
#define HN WSP(bf16, WS_HN)
#define VBUF WSP(bf16, WS_VBUF)
#define UG WSP(bf16, WS_UG)
#define CONCAT WSP(bf16, WS_CONCAT)
#define GB WSP(bf16, WS_G)
#define H1B WSP(bf16, WS_H1B)
#define QBUF WSP(bf16, WS_QBUF)
#define PBUF WSP(bf16, WS_PBUF)
#define OBUF WSP(bf16, WS_OBUF)
#define XG WSP(bf16, WS_XG)
#define HID WSP(bf16, WS_HID)
#define HIST WSP(int, WS_HIST)
#define TPREF WSP(int, WS_TPREF)
#define TOKE WSP(int, WS_TOKE)
#define TOKG WSP(float, WS_TOKG)
#define TOKS WSP(int, WS_TOKS)
#define RSTD3 WSP(float, WS_RSTD3)
#define SGATE WSP(float, WS_SGATE)
#define RS1 WSP(float, WS_RS1)
#define WRH WSP(bf16, WS_W36)
#define WRL WSP(bf16, WS_W36 + 48 * 1024 * 2)
#define SSMC WSP(float, WS_KMAT)
__global__ void __launch_bounds__(NTHR, 2) mk_fwd(Args args) {
    extern __shared__ __attribute__((aligned(16))) unsigned char lds_raw[];
    LAS unsigned char* lds = (LAS unsigned char*)lds_raw;
    const int wave = __builtin_amdgcn_readfirstlane((int)threadIdx.x >> 6);
#define PH_IDS int lane = lane_id(); asm volatile("" : "+v"(lane)); const int tid = wave * 64 + lane
    const int G = gridDim.x, c = blockIdx.x;
    const int vcu = (G % 8 == 0) ? (c % 8) * (G / 8) + c / 8 : c;
    const int gw = vcu * NWAVES + wave, NGW = G * NWAVES;
    unsigned char* ws = args.ws;
    volatile LAS unsigned* LCTL = (volatile LAS unsigned*)(lds + LCTL_OFF);
    { PH_IDS; for (int u = tid; u < 128; u += NTHR) LCTL[u] = 0u; }
    __syncthreads();
    XcdBarrier bar; bar.bar = (unsigned*)(ws + WS_CTL) + CW_BAR; bar.x = 0; bar.st = nullptr; bar.w0 = 0;
    if (!MK_PER_PHASE) bar = xcd_barrier_post((unsigned*)(ws + WS_CTL) + CW_BAR, LCTL + 8);
#define GRID_BAR() do { if (!MK_PER_PHASE) xcd_barrier(bar); } while (0)
    const int lo = args.ph_lo, hi = args.ph_hi;
#ifndef PH_MASK
#define PH_MASK 0x1fff
#endif
#define IN(k) (((PH_MASK >> (k)) & 1) && lo <= (k) && (k) < hi)
#define BOTH(k) (IN(k) && IN((k) + 1))
#define PHASE(k) if (IN(k))

    PHASE(0) {
        PH_IDS; (void)tid;
        const int gt = gw * 64 + lane, NGT = NGW * 64;
        for (int idx = gt; idx < NG * NP; idx += NGT) { const int g = idx >> 6, p = idx & 63; double lr, li, cr, ci; ssm_consts(args.in[8], args.in[9], args.in[10], g, p, lr, li, cr, ci);
            float ar, ai; cpow_d(lr, li, 1, ar, ai); float* o = SSMC + (size_t)idx * 8; o[0] = (float)lr; o[1] = (float)li; o[2] = (float)cr; o[3] = (float)ci; o[4] = ar; o[5] = ai; o[6] = 0.f; o[7] = 0.f; }
        for (int idx = gt; idx < 4 * 256 * 128; idx += NGT) { const int pn = idx >> 15, np = (idx >> 7) & 255, k = idx & 127; const int bj = np >> 7, gl = (np >> 4) & 7, e = np & 15; const int g = pn * 8 + gl;
            const float v = ((k >> 4) == gl) ? args.in[16][(size_t)(g * 16 + (k & 15)) * 32 + bj * 16 + e] : 0.f; GLUBT[idx] = (bf16)f2bf(v); }
        for (int idx = gt; idx < 48 * D; idx += NGT) { const int q = idx >> 10, k = idx & 1023; const float w = (q < NCOLR) ? args.in[24][k] * (q < 4 ? args.in[25][k * 4 + q] : args.in[27][k * 32 + q - 4]) : 0.f;
            const unsigned hb = f2bf(w); WRH[idx] = (bf16)hb; WRL[idx] = (bf16)f2bf(w - bf2f(hb)); }
        for (int m = gw; m < T; m += NGW) rms_row_to_bf16(X + (size_t)m * D, args.in[2], HN + (size_t)m * D, lane);
        for (int m = gw; m < TM; m += NGW) rms_row_to_bf16(args.in[1] + (size_t)m * D, args.in[19], MEMN + (size_t)m * D, lane);
        LAS float* scr = (LAS float*)(lds + wave * 16384);
        constexpr int I_IN = 16 * 48, I_SQ = 16 * 32, I_E = 768, NITEMS = I_IN + 5 * I_SQ + NE * I_E;
        for (int it = gw; it < NITEMS; it += NGW) {
            int r = it;
            if (r < I_IN) { const int kb = r / 48, nb = r % 48, n0 = nb * 32; const int dst = (n0 < 1024) ? (((n0 & 511) >> 7) * 256 + (n0 >> 9) * 128 + (n0 & 127)) : n0;
                transpose_item(args.in[3], 1536, WIN_T, 1024, kb * 64, n0, dst, nullptr, scr, lane); continue; } r -= I_IN;
            if (r < 5 * I_SQ) { const int w = r / I_SQ, q = r % I_SQ, kb = q / 32, n0 = (q % 32) * 32;
                const float* src = (w == 0) ? args.in[17] : (w == 1) ? args.in[20] : (w == 2) ? args.in[21] : (w == 3) ? args.in[22] : args.in[23];
                bf16* dstp = (w == 0) ? WOUT_T : (w == 1) ? WQ_T : (w == 2) ? WKV_T : (w == 3) ? WKV_T + (size_t)1024 * 1024 : WO_T;
                transpose_item(src, 1024, dstp, 1024, kb * 64, n0, n0, (w == 1) ? args.in[18] : nullptr, scr, lane); continue; } r -= 5 * I_SQ;
            { const int e = r / I_E, q = r % I_E;
              if (q < 512) { const int which = q >> 8, qq = q & 255, kb = qq >> 4, n0 = (qq & 15) * 32;
                  transpose_item((which ? args.in[30] : args.in[29]) + (size_t)e * 1024 * 512, 512, WUP_T + (size_t)e * 1024 * 1024, 1024, kb * 64, n0, (n0 >> 7) * 256 + which * 128 + (n0 & 127), nullptr, scr, lane); }
              else { const int qq = q - 512, kb = qq >> 5, n0 = (qq & 31) * 32;
                  transpose_item(args.in[31] + (size_t)e * 512 * 1024, 1024, WDN_T + (size_t)e * 1024 * 512, 512, kb * 64, n0, n0, nullptr, scr, lane); } }
        }
        if (BOTH(0)) GRID_BAR();
    }

    PHASE(1) {
        PH_IDS; (void)tid;
        { Gemm g{HN, WIN_T, 1024, 1024, 1024}; SchedGrid S; S.nM = 64; S.nN = 6; S.G = G; S.c = c; S.atile = 256ll * 1024 * 2; S.btile = 256ll * 1024 * 2; S.acol = 0;
          EpiIn E{VBUF, UG}; pg8::gemm_phase<EpiIn, SchedGrid, true, true>(lds, g, S, E, wave); }
        if (c >= 128) {
            if (c < 144) { Gemm g{MEMN, WKV_T, 1024, 1024, 1024}; SchedOne S; const int L = c - 128; S.have = true; S.u0.pm = L >> 3; S.u0.pn = L & 7; S.u0.aoff = (long long)(L >> 3) * 256 * 1024 * 2; S.u0.boff = (long long)(L & 7) * 256 * 1024 * 2;
                EpiKV E{KPROJ, VT}; pg8::gemm_phase<EpiKV, SchedOne, true, true>(lds, g, S, E, wave); }
            if (c >= 144) {
            const int sidx = (c - 144) * NTHR + tid, NS = 112 * NTHR;
            const float* Bre = args.in[11]; const float* Bim = args.in[12]; const float* Cre = args.in[13]; const float* Cim = args.in[14];
            for (int idx = sidx - 32768; idx >= 0 && idx < NG * 128; idx += NS) { const int g = idx >> 7, q = idx & 127, p = q & 63; const float* sc = SSMC + (size_t)(g * NP + p) * 8;
                float zr = sc[2], zi = sc[3]; const float ar = sc[4], ai = sc[5];
                f32x4 br[4], bi[4];
#pragma unroll
                for (int k = 0; k < 4; ++k) { br[k] = *(const f32x4*)(Bre + (size_t)(g * NP + p) * 16 + 4 * k); bi[k] = *(const f32x4*)(Bim + (size_t)(g * NP + p) * 16 + 4 * k); }
                for (int j = CH - 1; j >= 0; --j) { f32x4 o[4];
#pragma unroll
                    for (int k = 0; k < 4; ++k) o[k] = (q < 64) ? (br[k] * zr - bi[k] * zi) : (bi[k] * zr + br[k] * zi);
                    bf16* d = ETAB + (size_t)(g * 128 + q) * KE + j * 16; *(u32x4*)d = pack8(o[0], o[1]); *(u32x4*)(d + 8) = pack8(o[2], o[3]);
                    const float t = zr * ar - zi * ai; zi = zr * ai + zi * ar; zr = t; } }
            for (int idx = (sidx >= 36864 ? sidx - 36864 : sidx + 20480); idx < NG * 16 * NP; idx += NS) { const int g = idx >> 10, cch = (idx >> 6) & 15, p = idx & 63; const float* sc = SSMC + (size_t)(g * NP + p) * 8; const float ar = sc[4], ai = sc[5];
                const float cr = Cre[(size_t)(g * 16 + cch) * NP + p], ci = Cim[(size_t)(g * 16 + cch) * NP + p]; float zr = cr * ar - ci * ai, zi = cr * ai + ci * ar;
                for (int i = 0; i < CH; ++i) { bf16* d = TOEP + (size_t)(g * 512 + toep_col(i, cch)) * KY + KE; d[p] = (bf16)f2bf(zr); d[NP + p] = (bf16)f2bf(-zi);
                    const float t = zr * ar - zi * ai; zi = zr * ai + zi * ar; zr = t; } }
            for (int idx = sidx; idx < NG * 256 * 4; idx += NS) { const int pq = idx & 3, cc = (idx >> 2) & 255, g = idx >> 10, c1 = cc >> 4, c2 = cc & 15;
                float ks[CH];
#pragma unroll
                for (int l = 0; l < CH; ++l) ks[l] = 0.f;
                for (int pp = 0; pp < 16; ++pp) { const int p = pq * 16 + pp; const float* sc = SSMC + (size_t)(g * NP + p) * 8;
                    const float br = Bre[(size_t)(g * NP + p) * 16 + c2], bi = Bim[(size_t)(g * NP + p) * 16 + c2], bbr = sc[2] * br - sc[3] * bi, bbi = sc[2] * bi + sc[3] * br;
                    const float cr = Cre[(size_t)(g * 16 + c1) * NP + p], ci = Cim[(size_t)(g * 16 + c1) * NP + p]; float zr = cr * bbr - ci * bbi, zi = cr * bbi + ci * bbr; const float ar = sc[4], ai = sc[5];
#pragma unroll
                    for (int l = 0; l < CH; ++l) { ks[l] += zr; const float t = zr * ar - zi * ai; zi = zr * ai + zi * ar; zr = t; } }
#pragma unroll
                for (int l = 0; l < CH; ++l) { ks[l] += __shfl_xor(ks[l], 1); ks[l] += __shfl_xor(ks[l], 2); }
#pragma unroll
                for (int l = 0; l < CH; ++l) if ((l & 3) == pq) { const bf16 v = (bf16)f2bf(ks[l]);
                    for (int i = l; i < CH; ++i) TOEP[(size_t)(g * 512 + toep_col(i, c1)) * KY + (i - l) * 16 + c2] = v; } }
            for (int idx = sidx; idx < NG * 512 * CH; idx += NS) { const int g = idx >> 14, n = (idx >> 5) & 511, j = idx & 31; const int i = (n >> 8) * 16 + ((n >> 3) & 15);
                if (j > i) { bf16* d = TOEP + (size_t)(g * 512 + n) * KY + j * 16; const u32x4 z = {0u, 0u, 0u, 0u}; *(u32x4*)d = z; *(u32x4*)(d + 8) = z; } }
            }
        }
        if (BOTH(1)) GRID_BAR();
    }

    PHASE(2) {
        PH_IDS; (void)tid;
        if (c < 64) { Gemm g{UG, ETAB, KY, KE, KE}; SchedOne S; S.have = true; S.u0.pm = c; S.u0.pn = 0; S.u0.aoff = (long long)c * 256 * KY * 2; S.u0.boff = (long long)(c >> 1) * 128 * KE * 2;
            EpiScan E{UG, args.in[8], args.in[9], args.in[10]}; pg8::gemm_phase<EpiScan, SchedOne, false, true>(lds, g, S, E, wave); }
        else {
            const int ch = tid; float w[CWID];
#pragma unroll
            for (int k = 0; k < CWID; ++k) w[k] = args.in[4][k * DCONV + ch];
            const float bias = args.in[5][ch];
            LAS float* outl = (LAS float*)lds;
            for (int tile = c - 64; tile < T / 64; tile += G - 64) {
                const int t0 = tile * 64, tb0 = (t0 >> 13) << 13; float win[CWID];
                win[0] = 0.f;
#pragma unroll
                for (int i = 0; i < CWID - 1; ++i) { const int tt = t0 - (CWID - 1) + i; win[i + 1] = (tt >= tb0) ? bf2f(VBUF[(size_t)tt * 512 + ch]) : 0.f; }
                conv_block<31>(win, w, VBUF + (size_t)t0 * 512 + ch, bias, outl + ch);
                conv_block<31>(win, w, VBUF + (size_t)(t0 + 31) * 512 + ch, bias, outl + 31 * 512 + ch);
                conv_block<2>(win, w, VBUF + (size_t)(t0 + 62) * 512 + ch, bias, outl + 62 * 512 + ch);
                __syncthreads();
                for (int r = 0; r < 8; ++r) { const int tok = wave * 8 + r; float v[8]; float s = 0.f;
#pragma unroll
                    for (int j = 0; j < 8; ++j) { v[j] = outl[tok * 512 + lane + 64 * j]; s += v[j]; }
                    const float mean = wave_sum(s) * (1.f / 512.f); float q = 0.f;
#pragma unroll
                    for (int j = 0; j < 8; ++j) { v[j] -= mean; q += v[j] * v[j]; }
                    const float rstd = 1.0f / sqrtf(wave_sum(q) * (1.f / 512.f) + EPS);
#pragma unroll
                    for (int j = 0; j < 8; ++j) { const int cch = lane + 64 * j; const float o = v[j] * rstd * args.in[6][cch] + args.in[7][cch]; CONCAT[(size_t)(t0 + tok) * 1024 + cch] = (bf16)f2bf(o * sigmoidf_(o)); } }
                __syncthreads();
            }
        }
        if (BOTH(2)) GRID_BAR();
    }

    PHASE(3) {
        PH_IDS; (void)tid;
        if (c < 128) { const int g = c >> 2, b = (c >> 1) & 1, pn = c & 1; Gemm gm{UG, TOEP, KY, KY, KY}; SchedOne S; S.have = true; S.u0.pm = g * 2 + b; S.u0.pn = pn;
            S.u0.aoff = (long long)(g * 2 + b) * 256 * KY * 2; S.u0.boff = (long long)(g * 512 + pn * 256) * KY * 2;
            EpiY E{UG, args.in[15], GB}; pg8::gemm_phase<EpiY, SchedOne, true, true>(lds, gm, S, E, wave); }
        if (BOTH(3)) GRID_BAR();
    }

    PHASE(4) {
        PH_IDS; (void)tid;
        { Gemm g{GB, GLUBT, 512, 128, 128}; SchedGrid S; S.nM = 64; S.nN = 4; S.G = G; S.c = c; S.atile = 256ll * 512 * 2; S.btile = 256ll * 128 * 2; S.acol = 128 * 2;
          EpiPair<0> E{CONCAT, 1024, 512}; pg8::gemm_phase<EpiPair<0>, SchedGrid, true, true>(lds, g, S, E, wave); }
        if (BOTH(4)) GRID_BAR();
    }

    PHASE(5) {
        PH_IDS; (void)tid;
        { Gemm g{CONCAT, WOUT_T, 1024, 1024, 1024}; SchedGrid S; S.nM = 64; S.nN = 4; S.G = G; S.c = c; S.atile = 256ll * 1024 * 2; S.btile = 256ll * 1024 * 2; S.acol = 0;
          EpiH1 E{X, OUT, H1B, RS1}; pg8::gemm_phase<EpiH1, SchedGrid, true, true>(lds, g, S, E, wave); }
        if (BOTH(5)) GRID_BAR();
    }

    PHASE(6) {
        PH_IDS; (void)tid;
        if (c < 256) {
            int pm, pn; pg8::static_unit(c, 64, 4, pm, pn); const int b = pm >> 5, h = pn;
            LAS float* rl = (LAS float*)(lds + EXT_OFF);
            for (int r = tid; r < 256; r += NTHR) { const float* p = RS1 + ((size_t)pm * 256 + r) * 16; float s = 0.f;
#pragma unroll
                for (int j = 0; j < 4; ++j) { const f32x4 v = *(const f32x4*)(p + 4 * j); s += (v[0] + v[1]) + (v[2] + v[3]); }
                rl[r] = 1.0f / sqrtf(s * (1.f / D) + EPS); }
            __syncthreads();
            SchedOne S; S.have = true; S.u0.pm = pm; S.u0.pn = pn;
            { Gemm g{H1B, WQ_T, 1024, 1024, 1024}; S.u0.aoff = (long long)pm * 256 * 1024 * 2; S.u0.boff = (long long)pn * 256 * 1024 * 2;
              EpiQ E{QBUF, rl}; pg8::gemm_phase<EpiQ, SchedOne, true, true>(lds, g, S, E, wave); }
            VM_WAIT(); __syncthreads();
            { Gemm g{QBUF, KPROJ, 1024, 1024, 256}; S.u0.aoff = ((long long)pm * 256 * 1024 + h * 256) * 2; S.u0.boff = ((long long)b * 256 * 1024 + h * 256) * 2;
              EpiSm E{PBUF}; pg8::gemm_phase<EpiSm, SchedOne, false, true>(lds, g, S, E, wave); }
            VM_WAIT(); __syncthreads();
            { Gemm g{PBUF, VT, 1024, 256, 256}; S.u0.aoff = ((long long)pm * 256 * 1024 + h * 256) * 2; S.u0.boff = (long long)(b * 4 + h) * 65536 * 2;
              EpiBf E{OBUF, 1024}; pg8::gemm_phase<EpiBf, SchedOne, true, true>(lds, g, S, E, wave); }
        }
        if (BOTH(6)) GRID_BAR();
    }

    PHASE(7) {
        PH_IDS; (void)tid;
        { Gemm g{OBUF, WO_T, 1024, 1024, 1024}; SchedGrid S; S.nM = 64; S.nN = 4; S.G = G; S.c = c; S.atile = 256ll * 1024 * 2; S.btile = 256ll * 1024 * 2; S.acol = 0;
          EpiH2 E{OUT}; pg8::gemm_phase<EpiH2, SchedGrid, true, true>(lds, g, S, E, wave); }
        if (BOTH(7)) GRID_BAR();
    }

    PHASE(8) {
        PH_IDS; (void)tid;
        for (int blk = c; blk < T / 64; blk += G) {
            const int t0 = blk * 64;
            LAS float* Lp = (LAS float*)lds;
            LAS float* Sp = (LAS float*)(lds + 8 * 64 * 48 * 4);
            {
                f32x4 ac[4][3]; float ssq[4];
#pragma unroll
                for (int mb = 0; mb < 4; ++mb) { ssq[mb] = 0.f;
#pragma unroll
                    for (int nb = 0; nb < 3; ++nb) ac[mb][nb] = (f32x4){0.f, 0.f, 0.f, 0.f}; }
                const int fr = lane & 15, fq = lane >> 4;
#pragma unroll 1
                for (int st = 0; st < 4; ++st) { const int k0 = wave * 128 + st * 32 + 8 * fq;
                    bf16x8 bh[3], bl[3];
#pragma unroll
                    for (int nb = 0; nb < 3; ++nb) { bh[nb] = *(const bf16x8*)(WRH + (size_t)(nb * 16 + fr) * 1024 + k0); bl[nb] = *(const bf16x8*)(WRL + (size_t)(nb * 16 + fr) * 1024 + k0); }
#pragma unroll
                    for (int mb = 0; mb < 4; ++mb) { const float* xp = OUT + (size_t)(t0 + mb * 16 + fr) * 1024 + k0; const f32x4 x0 = *(const f32x4*)xp, x1 = *(const f32x4*)(xp + 4);
                        ssq[mb] += (x0[0] * x0[0] + x0[1] * x0[1]) + (x0[2] * x0[2] + x0[3] * x0[3]) + (x1[0] * x1[0] + x1[1] * x1[1]) + (x1[2] * x1[2] + x1[3] * x1[3]);
                        const u32x4 hw = pack8(x0, x1);
                        f32x4 r0, r1; r0[0] = x0[0] - bflo(hw.x); r0[1] = x0[1] - bfhi(hw.x); r0[2] = x0[2] - bflo(hw.y); r0[3] = x0[3] - bfhi(hw.y);
                        r1[0] = x1[0] - bflo(hw.z); r1[1] = x1[1] - bfhi(hw.z); r1[2] = x1[2] - bflo(hw.w); r1[3] = x1[3] - bfhi(hw.w);
                        const u32x4 lw = pack8(r0, r1);
                        const bf16x8 ah = __builtin_bit_cast(bf16x8, hw), al = __builtin_bit_cast(bf16x8, lw);
#pragma unroll
                        for (int nb = 0; nb < 3; ++nb) { ac[mb][nb] = __builtin_amdgcn_mfma_f32_16x16x32_bf16(ah, bh[nb], ac[mb][nb], 0, 0, 0);
                            ac[mb][nb] = __builtin_amdgcn_mfma_f32_16x16x32_bf16(al, bh[nb], ac[mb][nb], 0, 0, 0); ac[mb][nb] = __builtin_amdgcn_mfma_f32_16x16x32_bf16(ah, bl[nb], ac[mb][nb], 0, 0, 0); } } }
#pragma unroll
                for (int mb = 0; mb < 4; ++mb) { float sv = ssq[mb]; sv += __shfl_xor(sv, 16); sv += __shfl_xor(sv, 32); if (fq == 0) Sp[wave * 64 + mb * 16 + fr] = sv;
#pragma unroll
                    for (int nb = 0; nb < 3; ++nb)
#pragma unroll
                        for (int r = 0; r < 4; ++r) Lp[(wave * 64 + mb * 16 + 4 * fq + r) * 48 + nb * 16 + fr] = ac[mb][nb][r]; }
            }
            LAS float* Lg = (LAS float*)(lds + EXT_OFF + 1024);
            LAS int* lh = (LAS int*)(lds + EXT_OFF + 1024 + 64 * 40 * 4);
            if (tid < 32) lh[tid] = 0;
            __syncthreads();
            for (int idx = tid; idx < 64 * (NCOLR + 1); idx += NTHR) { const int tok = idx & 63, q = idx >> 6; float s = 0.f;
#pragma unroll
                for (int w8 = 0; w8 < 8; ++w8) s += (q < NCOLR) ? Lp[(w8 * 64 + tok) * 48 + q] : Sp[w8 * 64 + tok];
                Lg[tok * 40 + q] = s; }
            __syncthreads();
            if (tid < 64) { const int t = t0 + tid; const LAS float* L = Lg + tid * 40; const float rstd = 1.0f / sqrtf(L[NCOLR] * (1.f / D) + EPS); RSTD3[t] = rstd;
                float gl[4]; int gi = 0; float gm;
#pragma unroll
                for (int q = 0; q < 4; ++q) gl[q] = L[q] * rstd + args.in[26][q];
                gm = gl[0];
#pragma unroll
                for (int q = 1; q < 4; ++q) if (gl[q] > gm) { gm = gl[q]; gi = q; }
                float gs = 0.f;
#pragma unroll
                for (int q = 0; q < 4; ++q) gs += expf(gl[q] - gm);
                const float gwt = 1.0f / gs;
                float el[8];
#pragma unroll
                for (int q = 0; q < 8; ++q) el[q] = L[4 + gi * 8 + q] * rstd + args.in[28][gi * 8 + q];
                int i1 = 0; float l1 = el[0];
#pragma unroll
                for (int q = 1; q < 8; ++q) if (el[q] > l1) { l1 = el[q]; i1 = q; }
                int i2 = -1; float l2 = -3.0e38f;
#pragma unroll
                for (int q = 0; q < 8; ++q) if (q != i1 && el[q] > l2) { l2 = el[q]; i2 = q; }
                const float p2 = 1.0f / (1.0f + expf(l1 - l2)), p1 = 1.0f - p2;
                const int e1 = gi * 8 + i1, e2 = gi * 8 + i2;
                TOKE[t * 2] = e1; TOKE[t * 2 + 1] = e2; TOKG[t * 2] = gwt * p1; TOKG[t * 2 + 1] = gwt * p2;
                atomicAdd((int*)&lh[e1], 1); atomicAdd((int*)&lh[e2], 1); }
            __syncthreads();
            if (tid < 32) HIST[blk * 32 + tid] = lh[tid];
            __syncthreads();
        }
        if (BOTH(8)) GRID_BAR();
    }

    PHASE(9) {
        PH_IDS; (void)tid;
        for (int blk = c; blk < T / 64; blk += G) {
            const int t0 = blk * 64;
            LAS int* li = (LAS int*)lds; LAS int* cnt = li; LAS int* wgoff = li + 32; LAS int* base = li + 64; LAS int* lcnt = li + 96; LAS int* tpl = li + 128; LAS int* sl = li + 192;
            { LAS int* ptot = li + 512; LAS int* poff = li + 1024;
              const int e = tid & 31, part = tid >> 5; int total = 0, off = 0;
#pragma unroll
              for (int j = 0; j < 16; ++j) { const int w8 = part * 16 + j; const int hv = HIST[w8 * 32 + e]; total += hv; off += (w8 < blk) ? hv : 0; }
              ptot[part * 32 + e] = total; poff[part * 32 + e] = off;
              __syncthreads();
              if (tid < 32) { int tt = 0, oo = 0;
#pragma unroll
                  for (int j = 0; j < 16; ++j) { tt += ptot[j * 32 + tid]; oo += poff[j * 32 + tid]; }
                  cnt[tid] = tt; wgoff[tid] = oo; lcnt[tid] = 0; } }
            __syncthreads();
            if (tid == 0) { int a = 0; for (int e = 0; e < 32; ++e) { tpl[e] = a; base[e] = a * 256; a += (cnt[e] + 255) >> 8; } tpl[32] = a; }
            __syncthreads();
            if (blk == 0 && tid < 33) TPREF[tid] = tpl[tid];
            if (tid < 128) { const int tok = t0 + (tid >> 1), k = tid & 1; const int e = TOKE[tok * 2 + k]; const int rank = atomicAdd((int*)&lcnt[e], 1); const int slot = base[e] + wgoff[e] + rank;
                TOKS[tok * 2 + k] = slot; SGATE[slot] = TOKG[tok * 2 + k]; sl[tid] = slot; }
            __syncthreads();
            for (int r = 0; r < 8; ++r) { const int tl = wave * 8 + r, tok = t0 + tl; const int s0 = sl[tl * 2], s1 = sl[tl * 2 + 1]; const float rstd = RSTD3[tok];
#pragma unroll
                for (int j = 0; j < 4; ++j) { const int col = (lane + 64 * j) * 4; const f32x4 v = *(const f32x4*)(OUT + (size_t)tok * 1024 + col), gn = *(const f32x4*)(args.in[24] + col);
                    u32x2 o; o.x = pk2(v[0] * rstd * gn[0], v[1] * rstd * gn[1]); o.y = pk2(v[2] * rstd * gn[2], v[3] * rstd * gn[3]);
                    *(u32x2*)(XG + (size_t)s0 * 1024 + col) = o; *(u32x2*)(XG + (size_t)s1 * 1024 + col) = o; } }
            __syncthreads();
        }
        if (BOTH(9)) GRID_BAR();
    }

    PHASE(10) {
        PH_IDS; (void)tid;
        volatile LAS int* tp = (volatile LAS int*)(lds + EXT_OFF + 8192);
        if (tid < 33) tp[tid] = TPREF[tid];
        __syncthreads();
        { Gemm g{XG, WUP_T, 1024, 1024, 1024}; SchedMoe S; S.tp = tp; S.G = G; S.c = c; S.atile = 256ll * 1024 * 2; S.bexp = 1024ll * 1024 * 2; S.btile = 256ll * 1024 * 2;
          EpiPair<1> E{HID, 512, 0}; pg8::gemm_phase<EpiPair<1>, SchedMoe, true, true>(lds, g, S, E, wave); }
        if (BOTH(10)) GRID_BAR();
    }

    PHASE(11) {
        PH_IDS; (void)tid;
        volatile LAS int* tp = (volatile LAS int*)(lds + EXT_OFF + 8192);
        if (tid < 33) tp[tid] = TPREF[tid];
        __syncthreads();
        { Gemm g{HID, WDN_T, 512, 512, 512}; SchedMoe S; S.tp = tp; S.G = G; S.c = c; S.atile = 256ll * 512 * 2; S.bexp = 1024ll * 512 * 2; S.btile = 256ll * 512 * 2;
          EpiDown E{XG, SGATE}; pg8::gemm_phase<EpiDown, SchedMoe, true, true>(lds, g, S, E, wave); }
        if (BOTH(11)) GRID_BAR();
    }

    PHASE(12) {
        PH_IDS; (void)tid;
        int ns0 = TOKS[gw * 2], ns1 = TOKS[gw * 2 + 1];
        for (int tok = gw; tok < T; tok += NGW) { const int s0 = ns0, s1 = ns1; if (tok + NGW < T) { ns0 = TOKS[(tok + NGW) * 2]; ns1 = TOKS[(tok + NGW) * 2 + 1]; } f32x4 v[4]; float ss = 0.f;
#pragma unroll
            for (int j = 0; j < 4; ++j) { const int col = (lane + 64 * j) * 4; v[j] = *(const f32x4*)(OUT + (size_t)tok * 1024 + col);
                const u32x2 a = *(const u32x2*)(XG + (size_t)s0 * 1024 + col), b2 = *(const u32x2*)(XG + (size_t)s1 * 1024 + col);
                v[j][0] += bflo(a.x) + bflo(b2.x); v[j][1] += bfhi(a.x) + bfhi(b2.x); v[j][2] += bflo(a.y) + bflo(b2.y); v[j][3] += bfhi(a.y) + bfhi(b2.y);
                ss += (v[j][0] * v[j][0] + v[j][1] * v[j][1]) + (v[j][2] * v[j][2] + v[j][3] * v[j][3]); }
            const float r = 1.0f / sqrtf(wave_sum(ss) * (1.f / D) + EPS);
#pragma unroll
            for (int j = 0; j < 4; ++j) { const int col = (lane + 64 * j) * 4; const f32x4 gn = *(const f32x4*)(args.in[32] + col); *(f32x4*)(OUT + (size_t)tok * 1024 + col) = v[j] * r * gn; } }
    }
#undef IN
#undef BOTH
#undef GRID_BAR
}

#ifndef PROBE_K
#define PROBE_K -1
#endif
extern "C" void kernel_launch(void* const* d_in, const int* in_sizes, int n_in, void* d_out, int out_size, void* d_ws, size_t ws_size, hipStream_t stream) {
    static int grid = 0;
    if (grid == 0) {
        if (n_in != 33 || in_sizes[0] != T * D || out_size != T * D || ws_size < WS_END) { fprintf(stderr, "kernel_launch: unexpected shapes (n_in %d, in0 %d, out %d, ws %zu); nothing launched\n", n_in, n_in > 0 ? in_sizes[0] : -1, out_size, ws_size); grid = -1; return; }
        int dev = 0, cus = 0, per_cu = 0;
        if (hipGetDevice(&dev) != hipSuccess || hipDeviceGetAttribute(&cus, hipDeviceAttributeMultiprocessorCount, dev) != hipSuccess) { grid = -1; return; }
        if (hipFuncSetAttribute((const void*)mk_fwd, hipFuncAttributeMaxDynamicSharedMemorySize, LDS_BYTES) != hipSuccess) { fprintf(stderr, "kernel_launch: hipFuncSetAttribute failed\n"); grid = -1; return; }
        if (hipOccupancyMaxActiveBlocksPerMultiprocessor(&per_cu, (const void*)mk_fwd, NTHR, LDS_BYTES) != hipSuccess || per_cu < 1) fprintf(stderr, "kernel_launch: note: occupancy query reports %d\n", per_cu);
        (void)hipGetLastError();
        grid = cus;
        if (grid != 256) { fprintf(stderr, "kernel_launch: built for a 256-CU device, got %d CUs; nothing launched\n", grid); grid = -1; return; }
    }
    if (grid < 0) return;
    if (hipMemsetAsync((char*)d_ws + WS_CTL, 0, CTL_ZERO_BYTES, stream) != hipSuccess) return;
    Args a{};
    for (int i = 0; i < 33; ++i) a.in[i] = (const float*)d_in[i];
    a.out = (float*)d_out; a.ws = (unsigned char*)d_ws;
#if MK_PER_PHASE
    for (int ph = 0; ph < NPHASE; ++ph) { a.ph_lo = ph; a.ph_hi = ph + 1; hipLaunchKernelGGL(mk_fwd, dim3(grid), dim3(NTHR), LDS_BYTES, stream, a); }
#else
#if PROBE_K >= 0
    a.ph_lo = 0; a.ph_hi = PROBE_K + 1; hipLaunchKernelGGL(mk_fwd, dim3(grid), dim3(NTHR), LDS_BYTES, stream, a);
    (void)hipMemsetAsync((char*)d_ws + WS_CTL, 0, CTL_ZERO_BYTES, stream);
    a.ph_lo = PROBE_K; a.ph_hi = NPHASE; hipLaunchKernelGGL(mk_fwd, dim3(grid), dim3(NTHR), LDS_BYTES, stream, a);
#else
    a.ph_lo = 0; a.ph_hi = NPHASE; hipLaunchKernelGGL(mk_fwd, dim3(grid), dim3(NTHR), LDS_BYTES, stream, a);
#endif
#endif
}
```

```cpp
#include <hip/hip_runtime.h>
#include <cstdio>
#include <cstdint>

#define LAS __attribute__((address_space(3)))
#define GAS __attribute__((address_space(1)))
#define CAS __attribute__((address_space(4)))
typedef unsigned short bf16;
typedef short bf16x8 __attribute__((ext_vector_type(8)));
typedef float f32x4 __attribute__((ext_vector_type(4)));
typedef float f32x2 __attribute__((ext_vector_type(2)));
typedef unsigned u32x4 __attribute__((ext_vector_type(4)));
typedef unsigned u32x2 __attribute__((ext_vector_type(2)));

#ifndef MK_PER_PHASE
#define MK_PER_PHASE 0
#endif

constexpr int NB = 2, SEQ = 8192, D = 1024, T = NB * SEQ, MEML = 256, TM = NB * MEML;
constexpr int DCONV = 512, CWID = 31, NG = 32, SGC = 16, NP = 64, NH = 4, HD = 256, NE = 32, EPG = 8, NGRP = 4, DE = 512;
constexpr int CH = 32, NCH = SEQ / CH, KE = CH * SGC, KY = KE + 2 * NP;
constexpr int CAP = 40960;
constexpr int NCOLR = 36;
constexpr float EPS = 1e-6f;
constexpr int NWAVES = 8, NTHR = 512, NPHASE = 13;

constexpr size_t MiB = 1u << 20, KiB = 1024;
constexpr size_t WS_CTL = 0, CTL_ZERO_BYTES = 32 * KiB;
constexpr int CW_BAR = 1024;
constexpr size_t WS_HIST = 1 * MiB, WS_TPREF = WS_HIST + 32 * KiB, WS_TOKE = WS_HIST + 64 * KiB, WS_TOKG = WS_HIST + 192 * KiB, WS_TOKS = WS_HIST + 320 * KiB,
                 WS_RSTD3 = WS_HIST + 448 * KiB, WS_SGATE = WS_HIST + 512 * KiB, WS_W36 = WS_HIST + 768 * KiB;
constexpr size_t WS_RS1 = 2 * MiB, WS_KMAT = 3 * MiB;
constexpr size_t WS_WIN = 8 * MiB, WS_WOUT = 11 * MiB, WS_WQ = 13 * MiB, WS_WKV = 15 * MiB, WS_WO = 19 * MiB, WS_TOEP = 21 * MiB, WS_ETAB = 41 * MiB, WS_GLUBT = 46 * MiB,
                 WS_MEMN = 47 * MiB, WS_KPROJ = 48 * MiB, WS_VT = 49 * MiB;
constexpr size_t WS_WUP = 50 * MiB, WS_WDN = 114 * MiB;
constexpr size_t WS_ACT = 146 * MiB;
constexpr size_t WS_HN = WS_ACT, WS_VBUF = WS_ACT + 32 * MiB, WS_UG = WS_ACT + 48 * MiB, WS_CONCAT = WS_ACT + 68 * MiB, WS_G = WS_ACT + 100 * MiB;
constexpr size_t WS_H1B = WS_ACT, WS_QBUF = WS_ACT + 32 * MiB, WS_PBUF = WS_ACT + 68 * MiB, WS_OBUF = WS_ACT + 100 * MiB;
constexpr size_t WS_XG = WS_ACT, WS_HID = WS_ACT + 80 * MiB;
constexpr size_t WS_END = 280 * MiB;
static_assert(WS_G + (size_t)T * 512 * 2 <= WS_END && WS_OBUF + (size_t)T * D * 2 <= WS_END && WS_HID + (size_t)CAP * DE * 2 <= WS_END && WS_UG + (size_t)NG * NB * NCH * KY * 2 <= WS_CONCAT, "d_ws map");

constexpr int RING_BYTES = 131072, EXT_OFF = RING_BYTES, EXT_BYTES = 16384, LCTL_OFF = EXT_OFF + EXT_BYTES, LDS_BYTES = LCTL_OFF + 512;

#define LDS_WAIT() asm volatile("s_waitcnt lgkmcnt(0)" ::: "memory")
#define VM_WAIT() asm volatile("s_waitcnt vmcnt(0)" ::: "memory")
__device__ __forceinline__ unsigned f2bf(float f) { unsigned u = __builtin_bit_cast(unsigned, f); return (u + 0x7fffu + ((u >> 16) & 1u)) >> 16; }
__device__ __forceinline__ unsigned pk2(float lo, float hi) { return f2bf(lo) | (f2bf(hi) << 16); }
__device__ __forceinline__ float bf2f(unsigned h) { return __builtin_bit_cast(float, h << 16); }
__device__ __forceinline__ float bflo(unsigned w) { return __builtin_bit_cast(float, w << 16); }
__device__ __forceinline__ float bfhi(unsigned w) { return __builtin_bit_cast(float, w & 0xffff0000u); }
__device__ __forceinline__ unsigned cvt_pk_bf16(float lo, float hi) { unsigned r; asm volatile("v_cvt_pk_bf16_f32 %0, %1, %2" : "=v"(r) : "v"(lo), "v"(hi)); return r; }
__device__ __forceinline__ u32x4 pack8(const f32x4 a, const f32x4 b) { u32x4 w; w.x = cvt_pk_bf16(a[0], a[1]); w.y = cvt_pk_bf16(a[2], a[3]); w.z = cvt_pk_bf16(b[0], b[1]); w.w = cvt_pk_bf16(b[2], b[3]); return w; }
__device__ __forceinline__ float sigmoidf_(float x) { return __builtin_amdgcn_rcpf(1.0f + __expf(-x)); }
__device__ __forceinline__ f32x4 sig4(f32x4 x) { f32x4 r; r[0] = sigmoidf_(x[0]); r[1] = sigmoidf_(x[1]); r[2] = sigmoidf_(x[2]); r[3] = sigmoidf_(x[3]); return r; }
__device__ __forceinline__ float gelu_tanh(float x) { const float z = 0.7978845608028654f * (x + 0.044715f * x * x * x); const float th = 1.0f - 2.0f * __builtin_amdgcn_rcpf(1.0f + __expf(2.0f * z)); return 0.5f * x * (1.0f + th); }
__device__ __forceinline__ int lane_id() { return (int)__builtin_amdgcn_mbcnt_hi(~0u, __builtin_amdgcn_mbcnt_lo(~0u, 0u)); }
__device__ __forceinline__ float wave_sum(float v) {
#pragma unroll
    for (int o = 1; o < 64; o <<= 1) v += __shfl_xor(v, o);
    return v;
}

namespace pg8 {
#define PG8_LAS __attribute__((address_space(3)))
typedef unsigned short bf16_t;
constexpr int BM = 256, BK = 64, HALF = 128, HTB = HALF * BK * 2  , STAGE_BYTES = 8 * HTB, NXCD = 8, WGM = 8;
__host__ __device__ __forceinline__ int lds_byte(int r, int c) { const int st = (r >> 4) * 2 + (c >> 5), rr = r & 15, cc = c & 31, ob = rr * 64 + cc * 2; return st * 1024 + (ob ^ (((ob >> 9) & 1) << 5)); }
__host__ __device__ __forceinline__ void stage_rc(int b, int& R, int& C) { const int st = b / 1024, sb = b % 1024, swz = sb ^ (((sb >> 9) & 1) << 5); R = (st >> 1) * 16 + swz / 64; C = (st & 1) * 32 + (swz % 64) / 2; }
__host__ __device__ __forceinline__ int perm32(int rho) { const int n = rho >> 4, i = rho & 15; return 8 * (i >> 2) + 4 * n + (i & 3); }

struct Unit { int pm, pn; long long aoff, boff; };
struct Gemm { const bf16_t* A; const bf16_t* Bt; int lda, ldb, K; };

__device__ __forceinline__ void static_unit(int L, int nM, int nN, int& pm, int& pn) {
    const int nwg = nM * nN; int wgid = L; { const int q = nwg / NXCD, r = nwg % NXCD, xcd = wgid % NXCD, off = wgid / NXCD; wgid = (xcd < r ? xcd * (q + 1) : r * (q + 1) + (xcd - r) * q) + off; }
    const int nig = WGM * nN, gid = wgid / nig, fm = gid * WGM, gsz = (nM - fm) < WGM ? (nM - fm) : WGM;
    pm = fm + ((wgid % nig) % gsz); pn = (wgid % nig) / gsz;
}
template <class Epi, class Sched, bool ALIGN_EPI = false, bool SP2 = false>
__device__ __forceinline__ void gemm_phase(PG8_LAS unsigned char* lds, const Gemm g, const Sched& S, const Epi& E, const int wave_id) {
    int lane_ = lane_id(); asm volatile("" : "+v"(lane_));
    const int wid = wave_id, lane = lane_, tid = wid * 64 + lane, wr = wid >> 2, wc = wid & 3, fr = lane & 15, fq = lane >> 4;
    const int K = g.K, nt = K / BK;
    unsigned voffA[2], voffB[2];
#pragma unroll
    for (int i = 0; i < 2; ++i) { int R, C; stage_rc(tid * 16 + i * 8192, R, C); const int Rb = Epi::PERM ? ((R & ~31) + perm32(R & 31)) : R;
        voffA[i] = (unsigned)(R * g.lda + C) * 2u; voffB[i] = (unsigned)(Rb * g.ldb + C) * 2u; }
    const size_t kstep = (size_t)(BK * 2);
    const size_t hstepA = (size_t)HALF * g.lda * 2, hstepB = (size_t)HALF * g.ldb * 2;
    const unsigned ldsw = (unsigned)wid * 1024u;
    const int aoff = lds_byte(wr * 64 + fr, fq * 8), boff = lds_byte(wc * 32 + fr, fq * 8);
#define PG8_SA(b, h) (((b) * 2 + (h)) * HTB)
#define PG8_SB(b, h) ((4 + (b) * 2 + (h)) * HTB)
#define PG8_STAGE(bufoff, gbase, voff) do { _Pragma("unroll") for (int _i = 0; _i < 2; ++_i) \
        __builtin_amdgcn_global_load_lds((const unsigned*)((const char*)(gbase) + (voff)[_i]), (PG8_LAS unsigned*)(lds + (bufoff) + ldsw + _i * 8192), 16, 0, 0); } while (0)
#define PG8_LDA(dst, b, h) do { _Pragma("unroll") for (int m = 0; m < 4; ++m) _Pragma("unroll") for (int k = 0; k < 2; ++k) dst[m][k] = *(const PG8_LAS bf16x8*)(lds + PG8_SA(b, h) + aoff + m * 2048 + k * 1024); } while (0)
#define PG8_LDB(dst, b, h) do { _Pragma("unroll") for (int n = 0; n < 2; ++n) _Pragma("unroll") for (int k = 0; k < 2; ++k) dst[n][k] = *(const PG8_LAS bf16x8*)(lds + PG8_SB(b, h) + boff + n * 2048 + k * 1024); } while (0)
#define PG8_MMA(ai, bj, At, Bt) do { __builtin_amdgcn_s_setprio(1); _Pragma("unroll") for (int m = 0; m < 4; ++m) _Pragma("unroll") for (int n = 0; n < 2; ++n) _Pragma("unroll") for (int k = 0; k < 2; ++k) \
        acc[ai][bj][m][n] = __builtin_amdgcn_mfma_f32_16x16x32_bf16(Bt[n][k], At[m][k], acc[ai][bj][m][n], 0, 0, 0); __builtin_amdgcn_s_setprio(0); } while (0)
#define PG8_WAIT_V(n) asm volatile("s_waitcnt vmcnt(" #n ")" ::: "memory")
#define PG8_WAIT_L(n) asm volatile("s_waitcnt lgkmcnt(" #n ")" ::: "memory")
#define PG8_BAR __builtin_amdgcn_s_barrier()
#define PG8_SCHED __builtin_amdgcn_sched_barrier(0)
    Unit cur, nxt; int ui = 0;
    if (!S.next(0, cur)) return;
    f32x4 acc[2][2][4][2];
#pragma unroll
    for (int a = 0; a < 2; ++a)
#pragma unroll
        for (int b = 0; b < 2; ++b)
#pragma unroll
            for (int m = 0; m < 4; ++m)
#pragma unroll
                for (int n = 0; n < 2; ++n) acc[a][b][m][n] = (f32x4){0.f, 0.f, 0.f, 0.f};
    bf16x8 At[4][2], B0[2][2], B1[2][2];
    const char* cA = (const char*)g.A + cur.aoff; const char* cB = (const char*)g.Bt + cur.boff;
    S.a_ready(cur);
    if constexpr (SP2) {
        PG8_STAGE(PG8_SB(0, 0), cB, voffB); PG8_STAGE(PG8_SB(0, 1), cB + hstepB, voffB); PG8_STAGE(PG8_SA(0, 0), cA, voffA); PG8_STAGE(PG8_SA(0, 1), cA + hstepA, voffA);
        if (wr == 1) PG8_BAR;
        PG8_WAIT_V(2); PG8_BAR;
        PG8_STAGE(PG8_SB(1, 0), cB + kstep, voffB); PG8_STAGE(PG8_SA(1, 0), cA + kstep, voffA); PG8_STAGE(PG8_SB(1, 1), cB + hstepB + kstep, voffB);
        PG8_WAIT_V(6); PG8_BAR;
    } else {
        PG8_STAGE(PG8_SB(0, 0), cB, voffB); PG8_STAGE(PG8_SA(0, 0), cA, voffA); PG8_STAGE(PG8_SB(0, 1), cB + hstepB, voffB); PG8_STAGE(PG8_SA(0, 1), cA + hstepA, voffA);
        if (wr == 1) PG8_BAR;
        PG8_WAIT_V(4); PG8_BAR;
        PG8_STAGE(PG8_SB(1, 0), cB + kstep, voffB); PG8_STAGE(PG8_SA(1, 0), cA + kstep, voffA); PG8_STAGE(PG8_SB(1, 1), cB + hstepB + kstep, voffB);
        PG8_WAIT_V(6); PG8_BAR;
    }
    for (;;) {
        const bool has_next = S.next(ui + 1, nxt);
        const char* nA = has_next ? (const char*)g.A + nxt.aoff : cA; const char* nB = has_next ? (const char*)g.Bt + nxt.boff : cB;
#pragma unroll 1
        for (int t = 0; t < nt; t += 2) {
            const bool last = (t == nt - 2);
            const char* a1 = cA + (size_t)(t + 1) * kstep;
            const char* a2 = last ? nA : cA + (size_t)(t + 2) * kstep; const char* b2 = last ? nB : cB + (size_t)(t + 2) * kstep;
            const char* a3 = a2 + kstep; const char* b3 = b2 + kstep;
            if (last && has_next) S.a_ready(nxt);
            if constexpr (SP2) {
            PG8_LDB(B0, 0, 0); PG8_LDB(B1, 0, 1); PG8_SCHED; PG8_LDA(At, 0, 0); PG8_STAGE(PG8_SA(1, 1), a1 + hstepA, voffA);
            PG8_WAIT_V(8); PG8_WAIT_L(0); PG8_BAR; PG8_MMA(0, 0, At, B0); PG8_MMA(0, 1, At, B1); PG8_BAR; PG8_SCHED;
            PG8_LDA(At, 0, 1); PG8_STAGE(PG8_SB(0, 0), b2, voffB); PG8_STAGE(PG8_SB(0, 1), b2 + hstepB, voffB); PG8_STAGE(PG8_SA(0, 0), a2, voffA);
            PG8_WAIT_V(8); PG8_WAIT_L(0); PG8_BAR; PG8_MMA(1, 0, At, B0); PG8_MMA(1, 1, At, B1); PG8_BAR; PG8_SCHED;
            PG8_LDB(B0, 1, 0); PG8_LDB(B1, 1, 1); PG8_SCHED; PG8_LDA(At, 1, 0); PG8_STAGE(PG8_SA(0, 1), a2 + hstepA, voffA);
            PG8_WAIT_V(8); PG8_WAIT_L(0); PG8_BAR; PG8_MMA(0, 0, At, B0); PG8_MMA(0, 1, At, B1); PG8_BAR; PG8_SCHED;
            PG8_LDA(At, 1, 1); PG8_STAGE(PG8_SB(1, 0), b3, voffB); PG8_STAGE(PG8_SB(1, 1), b3 + hstepB, voffB); PG8_STAGE(PG8_SA(1, 0), a3, voffA);
            PG8_WAIT_V(8); PG8_WAIT_L(0); PG8_BAR; PG8_MMA(1, 0, At, B0); PG8_MMA(1, 1, At, B1); PG8_BAR; PG8_SCHED;
            } else {
            PG8_LDB(B0, 0, 0); PG8_SCHED; PG8_LDA(At, 0, 0); PG8_STAGE(PG8_SA(1, 1), a1 + hstepA, voffA);
            PG8_WAIT_L(8); PG8_BAR; PG8_WAIT_L(0); PG8_MMA(0, 0, At, B0); PG8_BAR; PG8_SCHED;
            PG8_LDB(B1, 0, 1); PG8_STAGE(PG8_SB(0, 0), b2, voffB);
            PG8_BAR; PG8_WAIT_L(0); PG8_MMA(0, 1, At, B1); PG8_BAR;
            PG8_LDA(At, 0, 1); PG8_STAGE(PG8_SA(0, 0), a2, voffA);
            PG8_BAR; PG8_WAIT_L(0); PG8_MMA(1, 0, At, B0); PG8_BAR; PG8_SCHED;
            PG8_STAGE(PG8_SB(0, 1), b2 + hstepB, voffB);
            PG8_WAIT_V(6); PG8_BAR; PG8_MMA(1, 1, At, B1); PG8_BAR;
            PG8_LDB(B0, 1, 0); PG8_SCHED; PG8_LDA(At, 1, 0); PG8_STAGE(PG8_SA(0, 1), a2 + hstepA, voffA);
            PG8_WAIT_L(8); PG8_BAR; PG8_WAIT_L(0); PG8_MMA(0, 0, At, B0); PG8_BAR; PG8_SCHED;
            PG8_LDB(B1, 1, 1); PG8_STAGE(PG8_SB(1, 0), b3, voffB);
            PG8_BAR; PG8_WAIT_L(0); PG8_MMA(0, 1, At, B1); PG8_BAR;
            PG8_LDA(At, 1, 1); PG8_STAGE(PG8_SA(1, 0), a3, voffA);
            PG8_BAR; PG8_WAIT_L(0); PG8_MMA(1, 0, At, B0); PG8_BAR; PG8_SCHED;
            PG8_STAGE(PG8_SB(1, 1), b3 + hstepB, voffB);
            PG8_WAIT_V(6); PG8_BAR; PG8_MMA(1, 1, At, B1); PG8_BAR;
            }
        }
        if constexpr (ALIGN_EPI) { if (wr == 0) PG8_BAR; }
        if constexpr (!Epi::AFTER_DRAIN) { E(acc, cur, wr, wc, fr, fq); S.done(cur); }
        if (!has_next) break;
#pragma unroll
        for (int a = 0; a < 2; ++a)
#pragma unroll
            for (int b = 0; b < 2; ++b)
#pragma unroll
                for (int m = 0; m < 4; ++m)
#pragma unroll
                    for (int n = 0; n < 2; ++n) acc[a][b][m][n] = (f32x4){0.f, 0.f, 0.f, 0.f};
        cur = nxt; cA = nA; cB = nB; ++ui;
        if constexpr (ALIGN_EPI) { if (wr == 1) PG8_BAR; }
    }
    PG8_WAIT_V(0);
    if constexpr (!ALIGN_EPI) { if (wr == 0) PG8_BAR; }
    PG8_BAR;
    if constexpr (Epi::AFTER_DRAIN) { E.fused(acc, cur, wr, wc, fr, fq, lds, wid, lane); S.done(cur); }
#undef PG8_SA
#undef PG8_SB
#undef PG8_STAGE
#undef PG8_LDA
#undef PG8_LDB
#undef PG8_MMA
#undef PG8_WAIT_V
#undef PG8_WAIT_L
#undef PG8_BAR
#undef PG8_SCHED
}

}

using pg8::Unit; using pg8::Gemm;
typedef f32x4 Acc[2][2][4][2];

struct SchedBase { __device__ __forceinline__ void a_ready(const Unit&) const {} __device__ __forceinline__ void done(const Unit&) const {} };
struct SchedGrid : SchedBase { int nM, nN, G, c; long long atile, btile, acol;
    __device__ __forceinline__ bool next(int i, Unit& u) const { const int L = i * G + c; if (L >= nM * nN) return false; pg8::static_unit(L, nM, nN, u.pm, u.pn);
        u.aoff = (long long)u.pm * atile + (long long)u.pn * acol; u.boff = (long long)u.pn * btile; return true; } };
struct SchedOne : SchedBase { Unit u0; bool have;
    __device__ __forceinline__ bool next(int i, Unit& u) const { if (i != 0 || !have) return false; u = u0; return true; } };
struct SchedMoe : SchedBase { volatile LAS int* tp; int G, c; long long atile, bexp, btile;
    __device__ __forceinline__ bool next(int i, Unit& u) const { const int L = i * G + c; const int nt4 = tp[32] * 4; if (L >= nt4) return false; const int tile = L >> 2; u.pm = tile; u.pn = L & 3;
        int e = 0;
#pragma unroll 1
        for (int k = 1; k < 32; ++k) e += (tp[k] <= tile) ? 1 : 0;
        u.aoff = (long long)tile * atile; u.boff = (long long)e * bexp + (long long)u.pn * btile; return true; } };

#define EPI_COMMON static constexpr bool PERM = true, AFTER_DRAIN = false;
struct EpiIn { EPI_COMMON bf16* V; bf16* UG;
    __device__ __forceinline__ void operator()(const Acc& acc, const Unit& u, int wr, int wc, int fr, int fq) const {
        const int row0 = u.pm * 256 + wr * 64 + fr;
        if (u.pn < 4) {
#pragma unroll
            for (int ai = 0; ai < 2; ++ai)
#pragma unroll
                for (int m = 0; m < 4; ++m) { const int row = row0 + ai * 128 + m * 16;
                    const f32x4 v0 = acc[ai][0][m][0] * sig4(acc[ai][1][m][0]), v1 = acc[ai][0][m][1] * sig4(acc[ai][1][m][1]);
                    *(u32x4*)(V + (size_t)row * 512 + u.pn * 128 + wc * 32 + 8 * fq) = pack8(v0, v1); }
        } else {
#pragma unroll
            for (int ai = 0; ai < 2; ++ai)
#pragma unroll
                for (int m = 0; m < 4; ++m) { const int row = row0 + ai * 128 + m * 16; const int b = row >> 13, chunk = (row >> 5) & 255, j = row & 31;
#pragma unroll
                    for (int bj = 0; bj < 2; ++bj) { const int cu = (u.pn - 4) * 256 + bj * 128 + wc * 32 + 8 * fq; const int g = cu >> 4, c0 = cu & 15;
                        *(u32x4*)(UG + ((size_t)((g * 2 + b) * 256 + chunk)) * KY + j * 16 + c0) = pack8(acc[ai][bj][m][0], acc[ai][bj][m][1]); } }
        }
    } };
struct EpiKV { EPI_COMMON bf16* KP; bf16* VT;
    __device__ __forceinline__ void operator()(const Acc& acc, const Unit& u, int wr, int wc, int fr, int fq) const {
        const int row0 = u.pm * 256 + wr * 64 + fr;
#pragma unroll
        for (int ai = 0; ai < 2; ++ai)
#pragma unroll
            for (int m = 0; m < 4; ++m) { const int row = row0 + ai * 128 + m * 16;
#pragma unroll
                for (int bj = 0; bj < 2; ++bj) { const int col = bj * 128 + wc * 32 + 8 * fq;
                    if (u.pn < 4) *(u32x4*)(KP + (size_t)row * 1024 + u.pn * 256 + col) = pack8(acc[ai][bj][m][0], acc[ai][bj][m][1]);
                    else { const int b = row >> 8, key = row & 255, h = u.pn - 4; bf16* vt = VT + ((size_t)(b * 4 + h) * 256 + col) * 256 + key;
#pragma unroll
                        for (int n = 0; n < 2; ++n)
#pragma unroll
                            for (int e = 0; e < 4; ++e) vt[(n * 4 + e) * 256] = (bf16)f2bf(acc[ai][bj][m][n][e]); } } }
    } };
struct EpiScan { static constexpr bool PERM = true, AFTER_DRAIN = true; bf16* UG; const float* Are; const float* Aim; const float* logdt;
    __device__ __forceinline__ void fused(const Acc& acc, const Unit& u, int wr, int wc, int fr, int fq, LAS unsigned char* lds, int wid, int lane) const {
        LAS float* El = (LAS float*)lds;
#pragma unroll
        for (int ai = 0; ai < 2; ++ai)
#pragma unroll
            for (int m = 0; m < 4; ++m) { const int row = ai * 128 + wr * 64 + m * 16 + fr;
#pragma unroll
                for (int n = 0; n < 2; ++n) { const int cc = (wc * 32 + 8 * fq + 4 * n) >> 2; *(LAS f32x4*)(El + row * 128 + ((cc ^ (row & 31)) << 2)) = acc[ai][0][m][n]; } }
        __syncthreads();
        if (wid == 0) {
            const int g = u.pm >> 1, p = lane;
            const double dt = exp((double)logdt[g]); const double lr = (double)Are[g * NP + p] * dt * CH, li = (double)Aim[g * NP + p] * dt * CH;
            const double mag = exp(lr); double sn, cs; sincos(li, &sn, &cs);
            const float ar = (float)(mag * cs), aim = (float)(mag * sn);
            float sr = 0.f, si = 0.f;
            bf16* ug = UG + (size_t)u.pm * 256 * KY + KE;
#pragma unroll 4
            for (int ch = 0; ch < NCH; ++ch) {
                ug[(size_t)ch * KY + p] = (bf16)f2bf(sr); ug[(size_t)ch * KY + NP + p] = (bf16)f2bf(si);
                const int sw = ch & 31; const float er = El[ch * 128 + ((((p >> 2) ^ sw) << 2) | (p & 3))], ei = El[ch * 128 + (((((64 + p) >> 2) ^ sw) << 2) | (p & 3))];
                const float nr = ar * sr - aim * si + er, ni = ar * si + aim * sr + ei; sr = nr; si = ni;
            }
        }
    } };
struct EpiY { EPI_COMMON const bf16* UG; const float* Dv; bf16* Gb;
    __device__ __forceinline__ void operator()(const Acc& acc, const Unit& u, int wr, int wc, int fr, int fq) const {
        const int g = u.pm >> 1, b = u.pm & 1, i = u.pn * 16 + 4 * wc + fq;
        f32x4 dv[4];
#pragma unroll
        for (int k = 0; k < 4; ++k) dv[k] = *(const f32x4*)(Dv + g * 16 + 4 * k);
#pragma unroll
        for (int ai = 0; ai < 2; ++ai)
#pragma unroll
            for (int m = 0; m < 4; ++m) { const int chunk = ai * 128 + wr * 64 + m * 16 + fr;
                const u32x4* up = (const u32x4*)(UG + ((size_t)u.pm * 256 + chunk) * KY + i * 16);
                const size_t t = (size_t)b * SEQ + chunk * CH + i;
#pragma unroll
                for (int bj = 0; bj < 2; ++bj) { const u32x4 uw = up[bj]; f32x4 y0 = acc[ai][bj][m][0], y1 = acc[ai][bj][m][1];
                    y0[0] += dv[2 * bj][0] * bflo(uw.x); y0[1] += dv[2 * bj][1] * bfhi(uw.x); y0[2] += dv[2 * bj][2] * bflo(uw.y); y0[3] += dv[2 * bj][3] * bfhi(uw.y);
                    y1[0] += dv[2 * bj + 1][0] * bflo(uw.z); y1[1] += dv[2 * bj + 1][1] * bfhi(uw.z); y1[2] += dv[2 * bj + 1][2] * bflo(uw.w); y1[3] += dv[2 * bj + 1][3] * bfhi(uw.w);
#pragma unroll
                    for (int e = 0; e < 4; ++e) { y0[e] = gelu_tanh(y0[e]); y1[e] = gelu_tanh(y1[e]); }
                    *(u32x4*)(Gb + t * 512 + g * 16 + bj * 8) = pack8(y0, y1); } }
    } };
template <int MODE> struct EpiPair { EPI_COMMON bf16* O; int ld, coloff;
    __device__ __forceinline__ void operator()(const Acc& acc, const Unit& u, int wr, int wc, int fr, int fq) const {
        const int row0 = u.pm * 256 + wr * 64 + fr;
#pragma unroll
        for (int ai = 0; ai < 2; ++ai)
#pragma unroll
            for (int m = 0; m < 4; ++m) { const int row = row0 + ai * 128 + m * 16; f32x4 v0, v1;
                if (MODE == 0) { v0 = acc[ai][0][m][0] * sig4(acc[ai][1][m][0]); v1 = acc[ai][0][m][1] * sig4(acc[ai][1][m][1]); }
                else { v0 = acc[ai][0][m][0] * sig4(acc[ai][0][m][0]) * acc[ai][1][m][0]; v1 = acc[ai][0][m][1] * sig4(acc[ai][0][m][1]) * acc[ai][1][m][1]; }
                *(u32x4*)(O + (size_t)row * ld + coloff + u.pn * 128 + wc * 32 + 8 * fq) = pack8(v0, v1); }
    } };
struct EpiH1 { EPI_COMMON const float* X; float* OUT; bf16* H1B; float* RS1;
    __device__ __forceinline__ void operator()(const Acc& acc, const Unit& u, int wr, int wc, int fr, int fq) const {
        const int row0 = u.pm * 256 + wr * 64 + fr;
#pragma unroll
        for (int ai = 0; ai < 2; ++ai)
#pragma unroll
            for (int m = 0; m < 4; ++m) { const int row = row0 + ai * 128 + m * 16; float ss = 0.f;
#pragma unroll
                for (int bj = 0; bj < 2; ++bj) { const size_t o = (size_t)row * 1024 + u.pn * 256 + bj * 128 + wc * 32 + 8 * fq;
                    const f32x4 h0 = *(const f32x4*)(X + o) + acc[ai][bj][m][0], h1 = *(const f32x4*)(X + o + 4) + acc[ai][bj][m][1];
                    *(f32x4*)(OUT + o) = h0; *(f32x4*)(OUT + o + 4) = h1; *(u32x4*)(H1B + o) = pack8(h0, h1);
                    ss += (h0[0] * h0[0] + h0[1] * h0[1]) + (h0[2] * h0[2] + h0[3] * h0[3]) + (h1[0] * h1[0] + h1[1] * h1[1]) + (h1[2] * h1[2] + h1[3] * h1[3]); }
                ss += __shfl_xor(ss, 16); ss += __shfl_xor(ss, 32);
                if (fq == 0) RS1[(size_t)row * 16 + u.pn * 4 + wc] = ss; }
    } };
struct EpiQ { EPI_COMMON bf16* Q; const LAS float* rl;
    __device__ __forceinline__ void operator()(const Acc& acc, const Unit& u, int wr, int wc, int fr, int fq) const {
#pragma unroll
        for (int ai = 0; ai < 2; ++ai)
#pragma unroll
            for (int m = 0; m < 4; ++m) { const int rloc = ai * 128 + wr * 64 + m * 16 + fr; const float s = rl[rloc] * 0.0625f; const size_t row = (size_t)u.pm * 256 + rloc;
#pragma unroll
                for (int bj = 0; bj < 2; ++bj) *(u32x4*)(Q + row * 1024 + u.pn * 256 + bj * 128 + wc * 32 + 8 * fq) = pack8(acc[ai][bj][m][0] * s, acc[ai][bj][m][1] * s); }
    } };
struct EpiSm { static constexpr bool PERM = true, AFTER_DRAIN = true; bf16* P;
    __device__ __forceinline__ void fused(Acc& acc, const Unit& u, int wr, int wc, int fr, int fq, LAS unsigned char* lds, int wid, int lane) const {
        LAS float* Xm = (LAS float*)lds; LAS float* Xs = Xm + 1024;
#pragma unroll
        for (int ai = 0; ai < 2; ++ai)
#pragma unroll
            for (int m = 0; m < 4; ++m) { float v = -3.0e38f;
#pragma unroll
                for (int bj = 0; bj < 2; ++bj)
#pragma unroll
                    for (int n = 0; n < 2; ++n)
#pragma unroll
                        for (int e = 0; e < 4; ++e) v = fmaxf(v, acc[ai][bj][m][n][e]);
                v = fmaxf(v, __shfl_xor(v, 16)); v = fmaxf(v, __shfl_xor(v, 32));
                if (fq == 0) Xm[(ai * 128 + wr * 64 + m * 16 + fr) * 4 + wc] = v; }
        __syncthreads();
#pragma unroll
        for (int ai = 0; ai < 2; ++ai)
#pragma unroll
            for (int m = 0; m < 4; ++m) { const f32x4 q = *(const LAS f32x4*)(Xm + (ai * 128 + wr * 64 + m * 16 + fr) * 4); const float rm = fmaxf(fmaxf(q[0], q[1]), fmaxf(q[2], q[3])); float s = 0.f;
#pragma unroll
                for (int bj = 0; bj < 2; ++bj)
#pragma unroll
                    for (int n = 0; n < 2; ++n)
#pragma unroll
                        for (int e = 0; e < 4; ++e) { const float pe = __expf(acc[ai][bj][m][n][e] - rm); acc[ai][bj][m][n][e] = pe; s += pe; }
                s += __shfl_xor(s, 16); s += __shfl_xor(s, 32);
                if (fq == 0) Xs[(ai * 128 + wr * 64 + m * 16 + fr) * 4 + wc] = s; }
        __syncthreads();
#pragma unroll
        for (int ai = 0; ai < 2; ++ai)
#pragma unroll
            for (int m = 0; m < 4; ++m) { const int rloc = ai * 128 + wr * 64 + m * 16 + fr; const f32x4 q = *(const LAS f32x4*)(Xs + rloc * 4); const float inv = __builtin_amdgcn_rcpf((q[0] + q[1]) + (q[2] + q[3]));
                const size_t row = (size_t)u.pm * 256 + rloc;
#pragma unroll
                for (int bj = 0; bj < 2; ++bj) *(u32x4*)(P + row * 1024 + u.pn * 256 + bj * 128 + wc * 32 + 8 * fq) = pack8(acc[ai][bj][m][0] * inv, acc[ai][bj][m][1] * inv); }
    } };
struct EpiBf { EPI_COMMON bf16* O; int ld;
    __device__ __forceinline__ void operator()(const Acc& acc, const Unit& u, int wr, int wc, int fr, int fq) const {
        const int row0 = u.pm * 256 + wr * 64 + fr;
#pragma unroll
        for (int ai = 0; ai < 2; ++ai)
#pragma unroll
            for (int m = 0; m < 4; ++m) { const int row = row0 + ai * 128 + m * 16;
#pragma unroll
                for (int bj = 0; bj < 2; ++bj) *(u32x4*)(O + (size_t)row * ld + u.pn * 256 + bj * 128 + wc * 32 + 8 * fq) = pack8(acc[ai][bj][m][0], acc[ai][bj][m][1]); }
    } };
struct EpiH2 { EPI_COMMON float* OUT;
    __device__ __forceinline__ void operator()(const Acc& acc, const Unit& u, int wr, int wc, int fr, int fq) const {
        const int row0 = u.pm * 256 + wr * 64 + fr;
#pragma unroll
        for (int ai = 0; ai < 2; ++ai)
#pragma unroll
            for (int m = 0; m < 4; ++m) { const int row = row0 + ai * 128 + m * 16;
#pragma unroll
                for (int bj = 0; bj < 2; ++bj) { float* o = OUT + (size_t)row * 1024 + u.pn * 256 + bj * 128 + wc * 32 + 8 * fq;
                    const f32x4 h0 = *(const f32x4*)o + acc[ai][bj][m][0], h1 = *(const f32x4*)(o + 4) + acc[ai][bj][m][1]; *(f32x4*)o = h0; *(f32x4*)(o + 4) = h1; } }
    } };
struct EpiDown { EPI_COMMON bf16* Y; const float* gate;
    __device__ __forceinline__ void operator()(const Acc& acc, const Unit& u, int wr, int wc, int fr, int fq) const {
        const int row0 = u.pm * 256 + wr * 64 + fr;
#pragma unroll
        for (int ai = 0; ai < 2; ++ai)
#pragma unroll
            for (int m = 0; m < 4; ++m) { const int row = row0 + ai * 128 + m * 16; const float gt = gate[row];
#pragma unroll
                for (int bj = 0; bj < 2; ++bj) *(u32x4*)(Y + (size_t)row * 1024 + u.pn * 256 + bj * 128 + wc * 32 + 8 * fq) = pack8(acc[ai][bj][m][0] * gt, acc[ai][bj][m][1] * gt); }
    } };

#define XB_TMO      128
#define XB_XCNT(j)  (256  + 64 * (j))
#define XB_XSUB(j)  (1280 + 64 * (j))
#define XB_XGEN(j)  (2304 + 64 * (j))
#define XB_TOP      3328
#define XB_TOPGEN   3392
#define XCD_BAR_WORDS 3456
#define XB_SPIN_CAP (1u << 18)

__device__ __forceinline__ unsigned xb_ld(unsigned* p)              { return __hip_atomic_load(p, __ATOMIC_RELAXED, __HIP_MEMORY_SCOPE_AGENT); }
__device__ __forceinline__ unsigned xb_add(unsigned* p, unsigned v) { return __hip_atomic_fetch_add(p, v, __ATOMIC_RELAXED, __HIP_MEMORY_SCOPE_AGENT); }
__device__ __forceinline__ unsigned xb_xcc_id() { return (unsigned)__builtin_amdgcn_s_getreg((3 << 11) | 20) & 0xFu; }
#define XB_SPIN(cond, bar) do { unsigned _sp = 0; while (cond) { __builtin_amdgcn_s_sleep(1); \
    if ((++_sp & 255u) == 0u) { if (xb_ld(&(bar)[XB_TMO])) break; if (_sp > XB_SPIN_CAP) { atomicAdd(&(bar)[XB_TMO], 1u); break; } } } } while (0)

struct XcdBarrier {
    unsigned* bar; unsigned x;
    unsigned w0;
    volatile LAS unsigned* st;
};

__device__ __forceinline__ XcdBarrier xcd_barrier_post(unsigned* bar, volatile LAS unsigned* st) {
    XcdBarrier b; b.bar = bar; b.x = xb_xcc_id(); b.st = st; b.w0 = (__builtin_amdgcn_readfirstlane((int)threadIdx.x >> 6) == 0) ? 1u : 0u;
    if (threadIdx.x == 0) (void)xb_add(&bar[XB_XCNT(b.x)], 1u);
    return b;
}
__device__ __forceinline__ void xcd_barrier_complete(unsigned* bar, unsigned x, unsigned& nloc, unsigned& nx) {
    const unsigned G = gridDim.x * gridDim.y * gridDim.z;
    unsigned sum, cnt, mine, sp = 0u;
    for (;;) {
        sum = 0u; cnt = 0u; mine = 0u;
#pragma unroll
        for (unsigned j = 0; j < 16; ++j) { const unsigned c = xb_ld(&bar[XB_XCNT(j)]); sum += c; cnt += (c > 0u) ? 1u : 0u; mine = (j == x) ? c : mine; }
        if (sum == G) break;
        __builtin_amdgcn_s_sleep(1);
        if ((++sp & 255u) == 0u) { if (xb_ld(&bar[XB_TMO])) break; if (sp > XB_SPIN_CAP) { atomicAdd(&bar[XB_TMO], 1u); break; } }
    }
    nloc = mine > 0u ? mine : 1u; nx = cnt > 0u ? cnt : 1u;
}

__device__ __forceinline__ void xcd_barrier(const XcdBarrier& b) {
    asm volatile("s_waitcnt vmcnt(0)" ::: "memory");
    __syncthreads();
    if (b.w0 && lane_id() == 0) {
        unsigned* bar = b.bar;
        __builtin_amdgcn_s_waitcnt(0);
        unsigned nloc = b.st[0], nx = b.st[1];
        if (nloc == 0u) { xcd_barrier_complete(bar, b.x, nloc, nx); b.st[0] = nloc; b.st[1] = nx; }
        const unsigned old = xb_add(&bar[XB_XSUB(b.x)], 1u);
        const unsigned gen = old / nloc;
        if (old + 1u == (gen + 1u) * nloc) {
            __builtin_amdgcn_fence(__ATOMIC_RELEASE, "agent");
            asm volatile("s_waitcnt vmcnt(0)" ::: "memory");
            const unsigned og = xb_add(&bar[XB_TOP], 1u);
            const unsigned tg = og / nx;
            if (og + 1u == (tg + 1u) * nx) xb_add(&bar[XB_TOPGEN], 1u);
            else XB_SPIN(xb_ld(&bar[XB_TOPGEN]) == tg, bar);
            __builtin_amdgcn_fence(__ATOMIC_ACQUIRE, "agent");
            xb_add(&bar[XB_XGEN(b.x)], 1u);
            asm volatile("s_waitcnt vmcnt(0)" ::: "memory");
        } else {
            XB_SPIN(xb_ld(&bar[XB_XGEN(b.x)]) == gen, bar);
            __builtin_amdgcn_fence(__ATOMIC_ACQUIRE, "agent");
            asm volatile("s_waitcnt vmcnt(0)" ::: "memory");
        }
    }
    __syncthreads();
}

__device__ __forceinline__ void tr_load(float (&v)[32], const float* W, int ldw, int k0, int n0, const float* kscale, int lane) {
#pragma unroll
    for (int i = 0; i < 32; ++i) { const int kk = 2 * i + (lane >> 5); v[i] = W[(size_t)(k0 + kk) * ldw + n0 + (lane & 31)]; }
    if (kscale) {
#pragma unroll
        for (int i = 0; i < 32; ++i) v[i] *= kscale[k0 + 2 * i + (lane >> 5)]; }
}
__device__ __forceinline__ void tr_finish(const float (&v)[32], bf16* WT, int ldwt, int k0, int dst_row0, LAS float* scr, int lane) {
#pragma unroll
    for (int i = 0; i < 32; ++i) scr[(2 * i + (lane >> 5)) * 33 + (lane & 31)] = v[i];
    LDS_WAIT(); asm volatile("" ::: "memory");
    const int c = lane & 7;
#pragma unroll
    for (int j = 0; j < 4; ++j) { const int n = (lane >> 3) + 8 * j; const LAS float* s = scr + (8 * c) * 33 + n;
        u32x4 o; o.x = pk2(s[0 * 33], s[1 * 33]); o.y = pk2(s[2 * 33], s[3 * 33]); o.z = pk2(s[4 * 33], s[5 * 33]); o.w = pk2(s[6 * 33], s[7 * 33]);
        *(u32x4*)(WT + (size_t)(dst_row0 + n) * ldwt + k0 + 8 * c) = o; }
    LDS_WAIT(); asm volatile("" ::: "memory");
}
__device__ __forceinline__ void transpose_item(const float* W, int ldw, bf16* WT, int ldwt, int k0, int n0, int dst_row0, const float* kscale, LAS float* scr, int lane) {
    float v[32]; tr_load(v, W, ldw, k0, n0, kscale, lane); tr_finish(v, WT, ldwt, k0, dst_row0, scr, lane);
}
__device__ __forceinline__ void rms_row_to_bf16(const float* xrow, const float* gain, bf16* orow, int lane) {
    f32x4 v[4]; float s = 0.f;
#pragma unroll
    for (int j = 0; j < 4; ++j) { v[j] = *(const f32x4*)(xrow + (lane + 64 * j) * 4); s += (v[j][0] * v[j][0] + v[j][1] * v[j][1]) + (v[j][2] * v[j][2] + v[j][3] * v[j][3]); }
    const float r = 1.0f / sqrtf(wave_sum(s) * (1.f / D) + EPS);
#pragma unroll
    for (int j = 0; j < 4; ++j) { const f32x4 gn = *(const f32x4*)(gain + (lane + 64 * j) * 4); u32x2 o; o.x = pk2(v[j][0] * r * gn[0], v[j][1] * r * gn[1]); o.y = pk2(v[j][2] * r * gn[2], v[j][3] * r * gn[3]);
        *(u32x2*)(orow + (lane + 64 * j) * 4) = o; }
}
__device__ __forceinline__ void ssm_consts(const float* Are, const float* Aim, const float* logdt, int g, int p, double& lr, double& li, double& cr, double& ci) {
    const double dt = exp((double)logdt[g]), a = (double)Are[g * NP + p], b = (double)Aim[g * NP + p];
    lr = a * dt; li = b * dt;
    const double mag = exp(lr); double sn, cs; sincos(li, &sn, &cs);
    const double x = mag * cs - 1.0, y = mag * sn, den = a * a + b * b;
    cr = (x * a + y * b) / den; ci = (y * a - x * b) / den;
}
__device__ __forceinline__ void cpow_d(double lr, double li, int m, float& zr, float& zi) { const double mag = exp(lr * m); double sn, cs; sincos(li * m, &sn, &cs); zr = (float)(mag * cs); zi = (float)(mag * sn); }

struct Args { const float* in[33]; float* out; unsigned char* ws; int ph_lo, ph_hi; };


constexpr int NITEMS_MOE = NE * 768;
constexpr int CW_QHEAD = 64;
#define CW_DONE(k) (128 + 64 * (k))
struct MoeIt { const float* src; bf16* dst; int ldw, ldwt, k0, n0, drow; };
__device__ __forceinline__ MoeIt moe_decode(int r, const float* w1, const float* w3, const float* w2, bf16* WUP, bf16* WDN) {
    const int e = r / 768, q = r % 768; MoeIt m;
    if (q < 512) { const int which = q >> 8, qq = q & 255, kb = qq >> 4, n0 = (qq & 15) * 32;
        m.src = (which ? w3 : w1) + (size_t)e * 1024 * 512; m.ldw = 512; m.dst = WUP + (size_t)e * 1024 * 1024; m.ldwt = 1024; m.k0 = kb * 64; m.n0 = n0; m.drow = (n0 >> 7) * 256 + which * 128 + (n0 & 127); }
    else { const int qq = q - 512, kb = qq >> 5, n0 = (qq & 31) * 32;
        m.src = w2 + (size_t)e * 512 * 1024; m.ldw = 1024; m.dst = WDN + (size_t)e * 1024 * 512; m.ldwt = 512; m.k0 = kb * 64; m.n0 = n0; m.drow = n0; }
    return m;
}
__device__ __forceinline__ void idle_convert(unsigned* ctl, int phase, int G, bool use_done, const float* w1, const float* w3, const float* w2, bf16* WUP, bf16* WDN, LAS unsigned char* lds, int wave, int lane, int tid) {
    volatile LAS int* bc = (volatile LAS int*)(lds + LCTL_OFF + 64);
    LAS float* scr = (LAS float*)(lds + wave * 17408);
    asm volatile("s_waitcnt vmcnt(0)" ::: "memory");
    __syncthreads();
    if (use_done && tid == 0) (void)xb_add(&ctl[CW_DONE(phase)], 1u);
    for (;;) {
        if (tid == 0) { int base = NITEMS_MOE; const bool stop = use_done && (xb_ld(&ctl[CW_DONE(phase)]) >= (unsigned)G); if (!stop) base = (int)xb_add(&ctl[CW_QHEAD], 16u); bc[0] = base; }
        __syncthreads();
        const int base = bc[0];
        __syncthreads();
        if (base >= NITEMS_MOE) break;
        const MoeIt a = moe_decode(base + 2 * wave, w1, w3, w2, WUP, WDN), b = moe_decode(base + 2 * wave + 1, w1, w3, w2, WUP, WDN);
        float va[32], vb[32];
        tr_load(va, a.src, a.ldw, a.k0, a.n0, nullptr, lane); tr_load(vb, b.src, b.ldw, b.k0, b.n0, nullptr, lane);
        tr_finish(va, a.dst, a.ldwt, a.k0, a.drow, scr, lane); tr_finish(vb, b.dst, b.ldwt, b.k0, b.drow, scr + 2176, lane);
    }
}

template <int NS> __device__ __forceinline__ void conv_block(float (&win)[CWID], const float (&w)[CWID], const bf16* vcol, float bias, LAS float* outl) {
#pragma unroll
    for (int ss = 0; ss < NS; ++ss) {
        win[ss % CWID] = bf2f(vcol[(size_t)ss * 512]);
        float a = bias;
#pragma unroll
        for (int k = 0; k < CWID; ++k) a += w[k] * win[(ss + k + 1) % CWID];
        outl[ss * 512] = a;
    }
}

__device__ __forceinline__ int toep_col(int i, int c) { return (i >> 4) * 256 + (c >> 3) * 128 + (i & 15) * 8 + (c & 7); }


#define X (args.in[0])
#define OUT (args.out)
#define WSP(T_, off) ((T_*)(ws + (off)))
#define WIN_T WSP(bf16, WS_WIN)
#define WOUT_T WSP(bf16, WS_WOUT)
#define WQ_T WSP(bf16, WS_WQ)
#define WKV_T WSP(bf16, WS_WKV)
#define WO_T WSP(bf16, WS_WO)
#define TOEP WSP(bf16, WS_TOEP)
#define ETAB WSP(bf16, WS_ETAB)
#define GLUBT WSP(bf16, WS_GLUBT)
#define MEMN WSP(bf16, WS_MEMN)
#define KPROJ WSP(bf16, WS_KPROJ)
#define VT WSP(bf16, WS_VT)
#define WUP_T WSP(bf16, WS_WUP)
#define WDN_T WSP(bf16, WS_WDN)
#define HN WSP(bf16, WS_HN)
#define VBUF WSP(bf16, WS_VBUF)
#define UG WSP(bf16, WS_UG)
#define CONCAT WSP(bf16, WS_CONCAT)
#define GB WSP(bf16, WS_G)
#define H1B WSP(bf16, WS_H1B)
#define QBUF WSP(bf16, WS_QBUF)
#define PBUF WSP(bf16, WS_PBUF)
#define OBUF WSP(bf16, WS_OBUF)
#define XG WSP(bf16, WS_XG)
#define HID WSP(bf16, WS_HID)
#define HIST WSP(int, WS_HIST)
#define TPREF WSP(int, WS_TPREF)
#define TOKE WSP(int, WS_TOKE)
#define TOKG WSP(float, WS_TOKG)
#define TOKS WSP(int, WS_TOKS)
#define RSTD3 WSP(float, WS_RSTD3)
#define SGATE WSP(float, WS_SGATE)
#define RS1 WSP(float, WS_RS1)
#define WRH WSP(bf16, WS_W36)
#define WRL WSP(bf16, WS_W36 + 48 * 1024 * 2)
#define SSMC WSP(float, WS_KMAT)
__global__ void __launch_bounds__(NTHR, 2) mk_fwd(Args args) {
    extern __shared__ __attribute__((aligned(16))) unsigned char lds_raw[];
    LAS unsigned char* lds = (LAS unsigned char*)lds_raw;
    const int wave = __builtin_amdgcn_readfirstlane((int)threadIdx.x >> 6);
#define PH_IDS int lane = lane_id(); asm volatile("" : "+v"(lane)); const int tid = wave * 64 + lane
    const int G = gridDim.x, c = blockIdx.x;
    const int vcu = (G % 8 == 0) ? (c % 8) * (G / 8) + c / 8 : c;
    const int gw = vcu * NWAVES + wave, NGW = G * NWAVES;
    unsigned char* ws = args.ws;
    volatile LAS unsigned* LCTL = (volatile LAS unsigned*)(lds + LCTL_OFF);
    { PH_IDS; for (int u = tid; u < 128; u += NTHR) LCTL[u] = 0u; }
    __syncthreads();
    XcdBarrier bar; bar.bar = (unsigned*)(ws + WS_CTL) + CW_BAR; bar.x = 0; bar.st = nullptr; bar.w0 = 0;
    if (!MK_PER_PHASE) bar = xcd_barrier_post((unsigned*)(ws + WS_CTL) + CW_BAR, LCTL + 8);
#define GRID_BAR() do { if (!MK_PER_PHASE) xcd_barrier(bar); } while (0)
    const int lo = args.ph_lo, hi = args.ph_hi;
#ifndef PH_MASK
#define PH_MASK 0x1fff
#endif
#define IN(k) (((PH_MASK >> (k)) & 1) && lo <= (k) && (k) < hi)
#define BOTH(k) (IN(k) && IN((k) + 1))
#define PHASE(k) if (IN(k))

    PHASE(0) {
        PH_IDS; (void)tid;
        const int gt = gw * 64 + lane, NGT = NGW * 64;
        for (int idx = gt; idx < NG * NP; idx += NGT) { const int g = idx >> 6, p = idx & 63; double lr, li, cr, ci; ssm_consts(args.in[8], args.in[9], args.in[10], g, p, lr, li, cr, ci);
            float ar, ai; cpow_d(lr, li, 1, ar, ai); float* o = SSMC + (size_t)idx * 8; o[0] = (float)lr; o[1] = (float)li; o[2] = (float)cr; o[3] = (float)ci; o[4] = ar; o[5] = ai; o[6] = 0.f; o[7] = 0.f; }
        for (int idx = gt; idx < 4 * 256 * 128; idx += NGT) { const int pn = idx >> 15, np = (idx >> 7) & 255, k = idx & 127; const int bj = np >> 7, gl = (np >> 4) & 7, e = np & 15; const int g = pn * 8 + gl;
            const float v = ((k >> 4) == gl) ? args.in[16][(size_t)(g * 16 + (k & 15)) * 32 + bj * 16 + e] : 0.f; GLUBT[idx] = (bf16)f2bf(v); }
        for (int idx = gt; idx < 48 * D; idx += NGT) { const int q = idx >> 10, k = idx & 1023; const float w = (q < NCOLR) ? args.in[24][k] * (q < 4 ? args.in[25][k * 4 + q] : args.in[27][k * 32 + q - 4]) : 0.f;
            const unsigned hb = f2bf(w); WRH[idx] = (bf16)hb; WRL[idx] = (bf16)f2bf(w - bf2f(hb)); }
        for (int m = gw; m < T; m += NGW) rms_row_to_bf16(X + (size_t)m * D, args.in[2], HN + (size_t)m * D, lane);
        for (int m = gw; m < TM; m += NGW) rms_row_to_bf16(args.in[1] + (size_t)m * D, args.in[19], MEMN + (size_t)m * D, lane);
        LAS float* scr = (LAS float*)(lds + wave * 16384);
        constexpr int I_IN = 16 * 48, I_SQ = 16 * 32, NITEMS = I_IN + 5 * I_SQ;
        for (int it = gw; it < NITEMS; it += NGW) {
            int r = it;
            if (r < I_IN) { const int kb = r / 48, nb = r % 48, n0 = nb * 32; const int dst = (n0 < 1024) ? (((n0 & 511) >> 7) * 256 + (n0 >> 9) * 128 + (n0 & 127)) : n0;
                transpose_item(args.in[3], 1536, WIN_T, 1024, kb * 64, n0, dst, nullptr, scr, lane); continue; } r -= I_IN;
            if (r < 5 * I_SQ) { const int w = r / I_SQ, q = r % I_SQ, kb = q / 32, n0 = (q % 32) * 32;
                const float* src = (w == 0) ? args.in[17] : (w == 1) ? args.in[20] : (w == 2) ? args.in[21] : (w == 3) ? args.in[22] : args.in[23];
                bf16* dstp = (w == 0) ? WOUT_T : (w == 1) ? WQ_T : (w == 2) ? WKV_T : (w == 3) ? WKV_T + (size_t)1024 * 1024 : WO_T;
                transpose_item(src, 1024, dstp, 1024, kb * 64, n0, n0, (w == 1) ? args.in[18] : nullptr, scr, lane); continue; }
        }
        if (BOTH(0)) GRID_BAR();
    }

    PHASE(1) {
        PH_IDS; (void)tid;
        { Gemm g{HN, WIN_T, 1024, 1024, 1024}; SchedGrid S; S.nM = 64; S.nN = 6; S.G = G; S.c = c; S.atile = 256ll * 1024 * 2; S.btile = 256ll * 1024 * 2; S.acol = 0;
          EpiIn E{VBUF, UG}; pg8::gemm_phase<EpiIn, SchedGrid, true, true>(lds, g, S, E, wave); }
        if (c >= 128) {
            if (c < 144) { Gemm g{MEMN, WKV_T, 1024, 1024, 1024}; SchedOne S; const int L = c - 128; S.have = true; S.u0.pm = L >> 3; S.u0.pn = L & 7; S.u0.aoff = (long long)(L >> 3) * 256 * 1024 * 2; S.u0.boff = (long long)(L & 7) * 256 * 1024 * 2;
                EpiKV E{KPROJ, VT}; pg8::gemm_phase<EpiKV, SchedOne, true, true>(lds, g, S, E, wave); }
            if (c >= 144) {
            const int sidx = (c - 144) * NTHR + tid, NS = 112 * NTHR;
            const float* Bre = args.in[11]; const float* Bim = args.in[12]; const float* Cre = args.in[13]; const float* Cim = args.in[14];
            for (int idx = sidx - 32768; idx >= 0 && idx < NG * 128; idx += NS) { const int g = idx >> 7, q = idx & 127, p = q & 63; const float* sc = SSMC + (size_t)(g * NP + p) * 8;
                float zr = sc[2], zi = sc[3]; const float ar = sc[4], ai = sc[5];
                f32x4 br[4], bi[4];
#pragma unroll
                for (int k = 0; k < 4; ++k) { br[k] = *(const f32x4*)(Bre + (size_t)(g * NP + p) * 16 + 4 * k); bi[k] = *(const f32x4*)(Bim + (size_t)(g * NP + p) * 16 + 4 * k); }
                for (int j = CH - 1; j >= 0; --j) { f32x4 o[4];
#pragma unroll
                    for (int k = 0; k < 4; ++k) o[k] = (q < 64) ? (br[k] * zr - bi[k] * zi) : (bi[k] * zr + br[k] * zi);
                    bf16* d = ETAB + (size_t)(g * 128 + q) * KE + j * 16; *(u32x4*)d = pack8(o[0], o[1]); *(u32x4*)(d + 8) = pack8(o[2], o[3]);
                    const float t = zr * ar - zi * ai; zi = zr * ai + zi * ar; zr = t; } }
            for (int idx = (sidx >= 36864 ? sidx - 36864 : sidx + 20480); idx < NG * 16 * NP; idx += NS) { const int g = idx >> 10, cch = (idx >> 6) & 15, p = idx & 63; const float* sc = SSMC + (size_t)(g * NP + p) * 8; const float ar = sc[4], ai = sc[5];
                const float cr = Cre[(size_t)(g * 16 + cch) * NP + p], ci = Cim[(size_t)(g * 16 + cch) * NP + p]; float zr = cr * ar - ci * ai, zi = cr * ai + ci * ar;
                for (int i = 0; i < CH; ++i) { bf16* d = TOEP + (size_t)(g * 512 + toep_col(i, cch)) * KY + KE; d[p] = (bf16)f2bf(zr); d[NP + p] = (bf16)f2bf(-zi);
                    const float t = zr * ar - zi * ai; zi = zr * ai + zi * ar; zr = t; } }
            for (int idx = sidx; idx < NG * 256 * 4; idx += NS) { const int pq = idx & 3, cc = (idx >> 2) & 255, g = idx >> 10, c1 = cc >> 4, c2 = cc & 15;
                float ks[CH];
#pragma unroll
                for (int l = 0; l < CH; ++l) ks[l] = 0.f;
                for (int pp = 0; pp < 16; ++pp) { const int p = pq * 16 + pp; const float* sc = SSMC + (size_t)(g * NP + p) * 8;
                    const float br = Bre[(size_t)(g * NP + p) * 16 + c2], bi = Bim[(size_t)(g * NP + p) * 16 + c2], bbr = sc[2] * br - sc[3] * bi, bbi = sc[2] * bi + sc[3] * br;
                    const float cr = Cre[(size_t)(g * 16 + c1) * NP + p], ci = Cim[(size_t)(g * 16 + c1) * NP + p]; float zr = cr * bbr - ci * bbi, zi = cr * bbi + ci * bbr; const float ar = sc[4], ai = sc[5];
#pragma unroll
                    for (int l = 0; l < CH; ++l) { ks[l] += zr; const float t = zr * ar - zi * ai; zi = zr * ai + zi * ar; zr = t; } }
#pragma unroll
                for (int l = 0; l < CH; ++l) { ks[l] += __shfl_xor(ks[l], 1); ks[l] += __shfl_xor(ks[l], 2); }
#pragma unroll
                for (int l = 0; l < CH; ++l) if ((l & 3) == pq) { const bf16 v = (bf16)f2bf(ks[l]);
                    for (int i = l; i < CH; ++i) TOEP[(size_t)(g * 512 + toep_col(i, c1)) * KY + (i - l) * 16 + c2] = v; } }
            for (int idx = sidx; idx < NG * 512 * CH; idx += NS) { const int g = idx >> 14, n = (idx >> 5) & 511, j = idx & 31; const int i = (n >> 8) * 16 + ((n >> 3) & 15);
                if (j > i) { bf16* d = TOEP + (size_t)(g * 512 + n) * KY + j * 16; const u32x4 z = {0u, 0u, 0u, 0u}; *(u32x4*)d = z; *(u32x4*)(d + 8) = z; } }
            }
        }
        idle_convert((unsigned*)(ws + WS_CTL), 1, G, true, args.in[29], args.in[30], args.in[31], WUP_T, WDN_T, lds, wave, lane, tid);
        if (BOTH(1)) GRID_BAR();
    }

    PHASE(2) {
        PH_IDS; (void)tid;
        if (c < 64) { Gemm g{UG, ETAB, KY, KE, KE}; SchedOne S; S.have = true; S.u0.pm = c; S.u0.pn = 0; S.u0.aoff = (long long)c * 256 * KY * 2; S.u0.boff = (long long)(c >> 1) * 128 * KE * 2;
            EpiScan E{UG, args.in[8], args.in[9], args.in[10]}; pg8::gemm_phase<EpiScan, SchedOne, false, true>(lds, g, S, E, wave); }
        else {
            const int ch = tid; float w[CWID];
#pragma unroll
            for (int k = 0; k < CWID; ++k) w[k] = args.in[4][k * DCONV + ch];
            const float bias = args.in[5][ch];
            LAS float* outl = (LAS float*)lds;
            for (int tile = c - 64; tile < T / 64; tile += G - 64) {
                const int t0 = tile * 64, tb0 = (t0 >> 13) << 13; float win[CWID];
                win[0] = 0.f;
#pragma unroll
                for (int i = 0; i < CWID - 1; ++i) { const int tt = t0 - (CWID - 1) + i; win[i + 1] = (tt >= tb0) ? bf2f(VBUF[(size_t)tt * 512 + ch]) : 0.f; }
                conv_block<31>(win, w, VBUF + (size_t)t0 * 512 + ch, bias, outl + ch);
                conv_block<31>(win, w, VBUF + (size_t)(t0 + 31) * 512 + ch, bias, outl + 31 * 512 + ch);
                conv_block<2>(win, w, VBUF + (size_t)(t0 + 62) * 512 + ch, bias, outl + 62 * 512 + ch);
                __syncthreads();
                for (int r = 0; r < 8; ++r) { const int tok = wave * 8 + r; float v[8]; float s = 0.f;
#pragma unroll
                    for (int j = 0; j < 8; ++j) { v[j] = outl[tok * 512 + lane + 64 * j]; s += v[j]; }
                    const float mean = wave_sum(s) * (1.f / 512.f); float q = 0.f;
#pragma unroll
                    for (int j = 0; j < 8; ++j) { v[j] -= mean; q += v[j] * v[j]; }
                    const float rstd = 1.0f / sqrtf(wave_sum(q) * (1.f / 512.f) + EPS);
#pragma unroll
                    for (int j = 0; j < 8; ++j) { const int cch = lane + 64 * j; const float o = v[j] * rstd * args.in[6][cch] + args.in[7][cch]; CONCAT[(size_t)(t0 + tok) * 1024 + cch] = (bf16)f2bf(o * sigmoidf_(o)); } }
                __syncthreads();
            }
        }
        idle_convert((unsigned*)(ws + WS_CTL), 2, G, true, args.in[29], args.in[30], args.in[31], WUP_T, WDN_T, lds, wave, lane, tid);
        if (BOTH(2)) GRID_BAR();
    }

    PHASE(3) {
        PH_IDS; (void)tid;
        if (c < 128) { const int g = c >> 2, b = (c >> 1) & 1, pn = c & 1; Gemm gm{UG, TOEP, KY, KY, KY}; SchedOne S; S.have = true; S.u0.pm = g * 2 + b; S.u0.pn = pn;
            S.u0.aoff = (long long)(g * 2 + b) * 256 * KY * 2; S.u0.boff = (long long)(g * 512 + pn * 256) * KY * 2;
            EpiY E{UG, args.in[15], GB}; pg8::gemm_phase<EpiY, SchedOne, true, true>(lds, gm, S, E, wave); }
        idle_convert((unsigned*)(ws + WS_CTL), 3, G, true, args.in[29], args.in[30], args.in[31], WUP_T, WDN_T, lds, wave, lane, tid);
        if (BOTH(3)) GRID_BAR();
    }

    PHASE(4) {
        PH_IDS; (void)tid;
        { Gemm g{GB, GLUBT, 512, 128, 128}; SchedGrid S; S.nM = 64; S.nN = 4; S.G = G; S.c = c; S.atile = 256ll * 512 * 2; S.btile = 256ll * 128 * 2; S.acol = 128 * 2;
          EpiPair<0> E{CONCAT, 1024, 512}; pg8::gemm_phase<EpiPair<0>, SchedGrid, true, true>(lds, g, S, E, wave); }
        if (BOTH(4)) GRID_BAR();
    }

    PHASE(5) {
        PH_IDS; (void)tid;
        { Gemm g{CONCAT, WOUT_T, 1024, 1024, 1024}; SchedGrid S; S.nM = 64; S.nN = 4; S.G = G; S.c = c; S.atile = 256ll * 1024 * 2; S.btile = 256ll * 1024 * 2; S.acol = 0;
          EpiH1 E{X, OUT, H1B, RS1}; pg8::gemm_phase<EpiH1, SchedGrid, true, true>(lds, g, S, E, wave); }
        if (BOTH(5)) GRID_BAR();
    }

    PHASE(6) {
        PH_IDS; (void)tid;
        if (c < 256) {
            int pm, pn; pg8::static_unit(c, 64, 4, pm, pn); const int b = pm >> 5, h = pn;
            LAS float* rl = (LAS float*)(lds + EXT_OFF);
            for (int r = tid; r < 256; r += NTHR) { const float* p = RS1 + ((size_t)pm * 256 + r) * 16; float s = 0.f;
#pragma unroll
                for (int j = 0; j < 4; ++j) { const f32x4 v = *(const f32x4*)(p + 4 * j); s += (v[0] + v[1]) + (v[2] + v[3]); }
                rl[r] = 1.0f / sqrtf(s * (1.f / D) + EPS); }
            __syncthreads();
            SchedOne S; S.have = true; S.u0.pm = pm; S.u0.pn = pn;
            { Gemm g{H1B, WQ_T, 1024, 1024, 1024}; S.u0.aoff = (long long)pm * 256 * 1024 * 2; S.u0.boff = (long long)pn * 256 * 1024 * 2;
              EpiQ E{QBUF, rl}; pg8::gemm_phase<EpiQ, SchedOne, true, true>(lds, g, S, E, wave); }
            VM_WAIT(); __syncthreads();
            { Gemm g{QBUF, KPROJ, 1024, 1024, 256}; S.u0.aoff = ((long long)pm * 256 * 1024 + h * 256) * 2; S.u0.boff = ((long long)b * 256 * 1024 + h * 256) * 2;
              EpiSm E{PBUF}; pg8::gemm_phase<EpiSm, SchedOne, false, true>(lds, g, S, E, wave); }
            VM_WAIT(); __syncthreads();
            { Gemm g{PBUF, VT, 1024, 256, 256}; S.u0.aoff = ((long long)pm * 256 * 1024 + h * 256) * 2; S.u0.boff = (long long)(b * 4 + h) * 65536 * 2;
              EpiBf E{OBUF, 1024}; pg8::gemm_phase<EpiBf, SchedOne, true, true>(lds, g, S, E, wave); }
        }
        if (BOTH(6)) GRID_BAR();
    }

    PHASE(7) {
        PH_IDS; (void)tid;
        { Gemm g{OBUF, WO_T, 1024, 1024, 1024}; SchedGrid S; S.nM = 64; S.nN = 4; S.G = G; S.c = c; S.atile = 256ll * 1024 * 2; S.btile = 256ll * 1024 * 2; S.acol = 0;
          EpiH2 E{OUT}; pg8::gemm_phase<EpiH2, SchedGrid, true, true>(lds, g, S, E, wave); }
        if (BOTH(7)) GRID_BAR();
    }

    PHASE(8) {
        PH_IDS; (void)tid;
        for (int blk = c; blk < T / 64; blk += G) {
            const int t0 = blk * 64;
            LAS float* Lp = (LAS float*)lds;
            LAS float* Sp = (LAS float*)(lds + 8 * 64 * 48 * 4);
            {
                f32x4 ac[4][3]; float ssq[4];
#pragma unroll
                for (int mb = 0; mb < 4; ++mb) { ssq[mb] = 0.f;
#pragma unroll
                    for (int nb = 0; nb < 3; ++nb) ac[mb][nb] = (f32x4){0.f, 0.f, 0.f, 0.f}; }
                const int fr = lane & 15, fq = lane >> 4;
#pragma unroll 1
                for (int st = 0; st < 4; ++st) { const int k0 = wave * 128 + st * 32 + 8 * fq;
                    bf16x8 bh[3], bl[3];
#pragma unroll
                    for (int nb = 0; nb < 3; ++nb) { bh[nb] = *(const bf16x8*)(WRH + (size_t)(nb * 16 + fr) * 1024 + k0); bl[nb] = *(const bf16x8*)(WRL + (size_t)(nb * 16 + fr) * 1024 + k0); }
#pragma unroll
                    for (int mb = 0; mb < 4; ++mb) { const float* xp = OUT + (size_t)(t0 + mb * 16 + fr) * 1024 + k0; const f32x4 x0 = *(const f32x4*)xp, x1 = *(const f32x4*)(xp + 4);
                        ssq[mb] += (x0[0] * x0[0] + x0[1] * x0[1]) + (x0[2] * x0[2] + x0[3] * x0[3]) + (x1[0] * x1[0] + x1[1] * x1[1]) + (x1[2] * x1[2] + x1[3] * x1[3]);
                        const u32x4 hw = pack8(x0, x1);
                        f32x4 r0, r1; r0[0] = x0[0] - bflo(hw.x); r0[1] = x0[1] - bfhi(hw.x); r0[2] = x0[2] - bflo(hw.y); r0[3] = x0[3] - bfhi(hw.y);
                        r1[0] = x1[0] - bflo(hw.z); r1[1] = x1[1] - bfhi(hw.z); r1[2] = x1[2] - bflo(hw.w); r1[3] = x1[3] - bfhi(hw.w);
                        const u32x4 lw = pack8(r0, r1);
                        const bf16x8 ah = __builtin_bit_cast(bf16x8, hw), al = __builtin_bit_cast(bf16x8, lw);
#pragma unroll
                        for (int nb = 0; nb < 3; ++nb) { ac[mb][nb] = __builtin_amdgcn_mfma_f32_16x16x32_bf16(ah, bh[nb], ac[mb][nb], 0, 0, 0);
                            ac[mb][nb] = __builtin_amdgcn_mfma_f32_16x16x32_bf16(al, bh[nb], ac[mb][nb], 0, 0, 0); ac[mb][nb] = __builtin_amdgcn_mfma_f32_16x16x32_bf16(ah, bl[nb], ac[mb][nb], 0, 0, 0); } } }
#pragma unroll
                for (int mb = 0; mb < 4; ++mb) { float sv = ssq[mb]; sv += __shfl_xor(sv, 16); sv += __shfl_xor(sv, 32); if (fq == 0) Sp[wave * 64 + mb * 16 + fr] = sv;
#pragma unroll
                    for (int nb = 0; nb < 3; ++nb)
#pragma unroll
                        for (int r = 0; r < 4; ++r) Lp[(wave * 64 + mb * 16 + 4 * fq + r) * 48 + nb * 16 + fr] = ac[mb][nb][r]; }
            }
            LAS float* Lg = (LAS float*)(lds + EXT_OFF + 1024);
            LAS int* lh = (LAS int*)(lds + EXT_OFF + 1024 + 64 * 40 * 4);
            if (tid < 32) lh[tid] = 0;
            __syncthreads();
            for (int idx = tid; idx < 64 * (NCOLR + 1); idx += NTHR) { const int tok = idx & 63, q = idx >> 6; float s = 0.f;
#pragma unroll
                for (int w8 = 0; w8 < 8; ++w8) s += (q < NCOLR) ? Lp[(w8 * 64 + tok) * 48 + q] : Sp[w8 * 64 + tok];
                Lg[tok * 40 + q] = s; }
            __syncthreads();
            if (tid < 64) { const int t = t0 + tid; const LAS float* L = Lg + tid * 40; const float rstd = 1.0f / sqrtf(L[NCOLR] * (1.f / D) + EPS); RSTD3[t] = rstd;
                float gl[4]; int gi = 0; float gm;
#pragma unroll
                for (int q = 0; q < 4; ++q) gl[q] = L[q] * rstd + args.in[26][q];
                gm = gl[0];
#pragma unroll
                for (int q = 1; q < 4; ++q) if (gl[q] > gm) { gm = gl[q]; gi = q; }
                float gs = 0.f;
#pragma unroll
                for (int q = 0; q < 4; ++q) gs += expf(gl[q] - gm);
                const float gwt = 1.0f / gs;
                float el[8];
#pragma unroll
                for (int q = 0; q < 8; ++q) el[q] = L[4 + gi * 8 + q] * rstd + args.in[28][gi * 8 + q];
                int i1 = 0; float l1 = el[0];
#pragma unroll
                for (int q = 1; q < 8; ++q) if (el[q] > l1) { l1 = el[q]; i1 = q; }
                int i2 = -1; float l2 = -3.0e38f;
#pragma unroll
                for (int q = 0; q < 8; ++q) if (q != i1 && el[q] > l2) { l2 = el[q]; i2 = q; }
                const float p2 = 1.0f / (1.0f + expf(l1 - l2)), p1 = 1.0f - p2;
                const int e1 = gi * 8 + i1, e2 = gi * 8 + i2;
                TOKE[t * 2] = e1; TOKE[t * 2 + 1] = e2; TOKG[t * 2] = gwt * p1; TOKG[t * 2 + 1] = gwt * p2;
                atomicAdd((int*)&lh[e1], 1); atomicAdd((int*)&lh[e2], 1); }
            __syncthreads();
            if (tid < 32) HIST[blk * 32 + tid] = lh[tid];
            __syncthreads();
        }
        idle_convert((unsigned*)(ws + WS_CTL), 8, G, false, args.in[29], args.in[30], args.in[31], WUP_T, WDN_T, lds, wave, lane, tid);
        if (BOTH(8)) GRID_BAR();
    }

    PHASE(9) {
        PH_IDS; (void)tid;
        for (int blk = c; blk < T / 64; blk += G) {
            const int t0 = blk * 64;
            LAS int* li = (LAS int*)lds; LAS int* cnt = li; LAS int* wgoff = li + 32; LAS int* base = li + 64; LAS int* lcnt = li + 96; LAS int* tpl = li + 128; LAS int* sl = li + 192;
            { LAS int* ptot = li + 512; LAS int* poff = li + 1024;
              const int e = tid & 31, part = tid >> 5; int total = 0, off = 0;
#pragma unroll
              for (int j = 0; j < 16; ++j) { const int w8 = part * 16 + j; const int hv = HIST[w8 * 32 + e]; total += hv; off += (w8 < blk) ? hv : 0; }
              ptot[part * 32 + e] = total; poff[part * 32 + e] = off;
              __syncthreads();
              if (tid < 32) { int tt = 0, oo = 0;
#pragma unroll
                  for (int j = 0; j < 16; ++j) { tt += ptot[j * 32 + tid]; oo += poff[j * 32 + tid]; }
                  cnt[tid] = tt; wgoff[tid] = oo; lcnt[tid] = 0; } }
            __syncthreads();
            if (tid == 0) { int a = 0; for (int e = 0; e < 32; ++e) { tpl[e] = a; base[e] = a * 256; a += (cnt[e] + 255) >> 8; } tpl[32] = a; }
            __syncthreads();
            if (blk == 0 && tid < 33) TPREF[tid] = tpl[tid];
            if (tid < 128) { const int tok = t0 + (tid >> 1), k = tid & 1; const int e = TOKE[tok * 2 + k]; const int rank = atomicAdd((int*)&lcnt[e], 1); const int slot = base[e] + wgoff[e] + rank;
                TOKS[tok * 2 + k] = slot; SGATE[slot] = TOKG[tok * 2 + k]; sl[tid] = slot; }
            __syncthreads();
            for (int r = 0; r < 8; ++r) { const int tl = wave * 8 + r, tok = t0 + tl; const int s0 = sl[tl * 2], s1 = sl[tl * 2 + 1]; const float rstd = RSTD3[tok];
#pragma unroll
                for (int j = 0; j < 4; ++j) { const int col = (lane + 64 * j) * 4; const f32x4 v = *(const f32x4*)(OUT + (size_t)tok * 1024 + col), gn = *(const f32x4*)(args.in[24] + col);
                    u32x2 o; o.x = pk2(v[0] * rstd * gn[0], v[1] * rstd * gn[1]); o.y = pk2(v[2] * rstd * gn[2], v[3] * rstd * gn[3]);
                    *(u32x2*)(XG + (size_t)s0 * 1024 + col) = o; *(u32x2*)(XG + (size_t)s1 * 1024 + col) = o; } }
            __syncthreads();
        }
        if (BOTH(9)) GRID_BAR();
    }

    PHASE(10) {
        PH_IDS; (void)tid;
        volatile LAS int* tp = (volatile LAS int*)(lds + EXT_OFF + 8192);
        if (tid < 33) tp[tid] = TPREF[tid];
        __syncthreads();
        { Gemm g{XG, WUP_T, 1024, 1024, 1024}; SchedMoe S; S.tp = tp; S.G = G; S.c = c; S.atile = 256ll * 1024 * 2; S.bexp = 1024ll * 1024 * 2; S.btile = 256ll * 1024 * 2;
          EpiPair<1> E{HID, 512, 0}; pg8::gemm_phase<EpiPair<1>, SchedMoe, true, true>(lds, g, S, E, wave); }
        if (BOTH(10)) GRID_BAR();
    }

    PHASE(11) {
        PH_IDS; (void)tid;
        volatile LAS int* tp = (volatile LAS int*)(lds + EXT_OFF + 8192);
        if (tid < 33) tp[tid] = TPREF[tid];
        __syncthreads();
        { Gemm g{HID, WDN_T, 512, 512, 512}; SchedMoe S; S.tp = tp; S.G = G; S.c = c; S.atile = 256ll * 512 * 2; S.bexp = 1024ll * 512 * 2; S.btile = 256ll * 512 * 2;
          EpiDown E{XG, SGATE}; pg8::gemm_phase<EpiDown, SchedMoe, true, true>(lds, g, S, E, wave); }
        if (BOTH(11)) GRID_BAR();
    }

    PHASE(12) {
        PH_IDS; (void)tid;
        int ns0 = TOKS[gw * 2], ns1 = TOKS[gw * 2 + 1];
        for (int tok = gw; tok < T; tok += NGW) { const int s0 = ns0, s1 = ns1; if (tok + NGW < T) { ns0 = TOKS[(tok + NGW) * 2]; ns1 = TOKS[(tok + NGW) * 2 + 1]; } f32x4 v[4]; float ss = 0.f;
#pragma unroll
            for (int j = 0; j < 4; ++j) { const int col = (lane + 64 * j) * 4; v[j] = *(const f32x4*)(OUT + (size_t)tok * 1024 + col);
                const u32x2 a = *(const u32x2*)(XG + (size_t)s0 * 1024 + col), b2 = *(const u32x2*)(XG + (size_t)s1 * 1024 + col);
                v[j][0] += bflo(a.x) + bflo(b2.x); v[j][1] += bfhi(a.x) + bfhi(b2.x); v[j][2] += bflo(a.y) + bflo(b2.y); v[j][3] += bfhi(a.y) + bfhi(b2.y);
                ss += (v[j][0] * v[j][0] + v[j][1] * v[j][1]) + (v[j][2] * v[j][2] + v[j][3] * v[j][3]); }
            const float r = 1.0f / sqrtf(wave_sum(ss) * (1.f / D) + EPS);
#pragma unroll
            for (int j = 0; j < 4; ++j) { const int col = (lane + 64 * j) * 4; const f32x4 gn = *(const f32x4*)(args.in[32] + col); *(f32x4*)(OUT + (size_t)tok * 1024 + col) = v[j] * r * gn; } }
    }
#undef IN
#undef BOTH
#undef GRID_BAR
}

#ifndef PROBE_K
#define PROBE_K -1
#endif
extern "C" void kernel_launch(void* const* d_in, const int* in_sizes, int n_in, void* d_out, int out_size, void* d_ws, size_t ws_size, hipStream_t stream) {
    static int grid = 0;
    if (grid == 0) {
        if (n_in != 33 || in_sizes[0] != T * D || out_size != T * D || ws_size < WS_END) { fprintf(stderr, "kernel_launch: unexpected shapes (n_in %d, in0 %d, out %d, ws %zu); nothing launched\n", n_in, n_in > 0 ? in_sizes[0] : -1, out_size, ws_size); grid = -1; return; }
        int dev = 0, cus = 0, per_cu = 0;
        if (hipGetDevice(&dev) != hipSuccess || hipDeviceGetAttribute(&cus, hipDeviceAttributeMultiprocessorCount, dev) != hipSuccess) { grid = -1; return; }
        if (hipFuncSetAttribute((const void*)mk_fwd, hipFuncAttributeMaxDynamicSharedMemorySize, LDS_BYTES) != hipSuccess) { fprintf(stderr, "kernel_launch: hipFuncSetAttribute failed\n"); grid = -1; return; }
        if (hipOccupancyMaxActiveBlocksPerMultiprocessor(&per_cu, (const void*)mk_fwd, NTHR, LDS_BYTES) != hipSuccess || per_cu < 1) fprintf(stderr, "kernel_launch: note: occupancy query reports %d\n", per_cu);
        (void)hipGetLastError();
        grid = cus;
        if (grid != 256) { fprintf(stderr, "kernel_launch: built for a 256-CU device, got %d CUs; nothing launched\n", grid); grid = -1; return; }
    }
    if (grid < 0) return;
    if (hipMemsetAsync((char*)d_ws + WS_CTL, 0, CTL_ZERO_BYTES, stream) != hipSuccess) return;
    Args a{};
    for (int i = 0; i < 33; ++i) a.in[i] = (const float*)d_in[i];
    a.out = (float*)d_out; a.ws = (unsigned char*)d_ws;
#if MK_PER_PHASE
    for (int ph = 0; ph < NPHASE; ++ph) { a.ph_lo = ph; a.ph_hi = ph + 1; hipLaunchKernelGGL(mk_fwd, dim3(grid), dim3(NTHR), LDS_BYTES, stream, a); }
#else
#if PROBE_K >= 0
    a.ph_lo = 0; a.ph_hi = PROBE_K + 1; hipLaunchKernelGGL(mk_fwd, dim3(grid), dim3(NTHR), LDS_BYTES, stream, a);
    (void)hipMemsetAsync((char*)d_ws + WS_CTL, 0, CTL_ZERO_BYTES, stream);
    a.ph_lo = PROBE_K; a.ph_hi = NPHASE; hipLaunchKernelGGL(mk_fwd, dim3(grid), dim3(NTHR), LDS_BYTES, stream, a);
#else
    a.ph_lo = 0; a.ph_hi = NPHASE; hipLaunchKernelGGL(mk_fwd, dim3(grid), dim3(NTHR), LDS_BYTES, stream, a);
#endif
#endif
}
```

```cpp
#include <hip/hip_runtime.h>
#include <cstdio>
#include <cstdint>

#define LAS __attribute__((address_space(3)))
#define GAS __attribute__((address_space(1)))
#define CAS __attribute__((address_space(4)))
typedef unsigned short bf16;
typedef short bf16x8 __attribute__((ext_vector_type(8)));
typedef float f32x4 __attribute__((ext_vector_type(4)));
typedef float f32x2 __attribute__((ext_vector_type(2)));
typedef unsigned u32x4 __attribute__((ext_vector_type(4)));
typedef unsigned u32x2 __attribute__((ext_vector_type(2)));

#ifndef MK_PER_PHASE
#define MK_PER_PHASE 0
#endif

constexpr int NB = 2, SEQ = 8192, D = 1024, T = NB * SEQ, MEML = 256, TM = NB * MEML;
constexpr int DCONV = 512, CWID = 31, NG = 32, SGC = 16, NP = 64, NH = 4, HD = 256, NE = 32, EPG = 8, NGRP = 4, DE = 512;
constexpr int CH = 32, NCH = SEQ / CH, KE = CH * SGC, KY = KE + 2 * NP;
constexpr int CAP = 40960;
constexpr int NCOLR = 36;
constexpr float EPS = 1e-6f;
constexpr int NWAVES = 8, NTHR = 512, NPHASE = 13;

constexpr size_t MiB = 1u << 20, KiB = 1024;
constexpr size_t WS_CTL = 0, CTL_ZERO_BYTES = 32 * KiB;
constexpr int CW_BAR = 1024;
constexpr size_t WS_HIST = 1 * MiB, WS_TPREF = WS_HIST + 32 * KiB, WS_TOKE = WS_HIST + 64 * KiB, WS_TOKG = WS_HIST + 192 * KiB, WS_TOKS = WS_HIST + 320 * KiB,
                 WS_RSTD3 = WS_HIST + 448 * KiB, WS_SGATE = WS_HIST + 512 * KiB, WS_W36 = WS_HIST + 768 * KiB;
constexpr size_t WS_RS1 = 2 * MiB, WS_KMAT = 3 * MiB, WS_QKT = 4 * MiB;
constexpr size_t WS_WIN = 8 * MiB, WS_WOUT = 11 * MiB, WS_WQ = 13 * MiB, WS_WKV = 15 * MiB, WS_WO = 19 * MiB, WS_TOEP = 21 * MiB, WS_ETAB = 41 * MiB, WS_GLUBT = 46 * MiB,
                 WS_MEMN = 47 * MiB, WS_KVP = 48 * MiB;
constexpr size_t WS_WUP = 50 * MiB, WS_WDN = 114 * MiB;
constexpr size_t WS_ACT = 146 * MiB;
constexpr size_t WS_HN = WS_ACT, WS_VBUF = WS_ACT + 32 * MiB, WS_UG = WS_ACT + 48 * MiB, WS_CONCAT = WS_ACT + 68 * MiB, WS_G = WS_ACT + 100 * MiB;
constexpr size_t WS_H1B = WS_ACT, WS_PBUF = WS_ACT + 68 * MiB, WS_VWOT = WS_ACT + 116 * MiB;
constexpr size_t WS_XG = WS_ACT, WS_HID = WS_ACT + 80 * MiB;
constexpr size_t WS_END = 280 * MiB;
static_assert(WS_G + (size_t)T * 512 * 2 <= WS_END && WS_VWOT + (size_t)4 * MiB <= WS_END && WS_HID + (size_t)CAP * DE * 2 <= WS_END && WS_UG + (size_t)NG * NB * NCH * KY * 2 <= WS_CONCAT, "d_ws map");

constexpr int RING_BYTES = 131072, EXT_OFF = RING_BYTES, EXT_BYTES = 16384, LCTL_OFF = EXT_OFF + EXT_BYTES, LDS_BYTES = LCTL_OFF + 512;

#define LDS_WAIT() asm volatile("s_waitcnt lgkmcnt(0)" ::: "memory")
#define VM_WAIT() asm volatile("s_waitcnt vmcnt(0)" ::: "memory")
__device__ __forceinline__ unsigned f2bf(float f) { unsigned u = __builtin_bit_cast(unsigned, f); return (u + 0x7fffu + ((u >> 16) & 1u)) >> 16; }
__device__ __forceinline__ unsigned pk2(float lo, float hi) { return f2bf(lo) | (f2bf(hi) << 16); }
__device__ __forceinline__ float bf2f(unsigned h) { return __builtin_bit_cast(float, h << 16); }
__device__ __forceinline__ float bflo(unsigned w) { return __builtin_bit_cast(float, w << 16); }
__device__ __forceinline__ float bfhi(unsigned w) { return __builtin_bit_cast(float, w & 0xffff0000u); }
__device__ __forceinline__ unsigned cvt_pk_bf16(float lo, float hi) { unsigned r; asm volatile("v_cvt_pk_bf16_f32 %0, %1, %2" : "=v"(r) : "v"(lo), "v"(hi)); return r; }
__device__ __forceinline__ u32x4 pack8(const f32x4 a, const f32x4 b) { u32x4 w; w.x = cvt_pk_bf16(a[0], a[1]); w.y = cvt_pk_bf16(a[2], a[3]); w.z = cvt_pk_bf16(b[0], b[1]); w.w = cvt_pk_bf16(b[2], b[3]); return w; }
__device__ __forceinline__ float sigmoidf_(float x) { return __builtin_amdgcn_rcpf(1.0f + __expf(-x)); }
__device__ __forceinline__ f32x4 sig4(f32x4 x) { f32x4 r; r[0] = sigmoidf_(x[0]); r[1] = sigmoidf_(x[1]); r[2] = sigmoidf_(x[2]); r[3] = sigmoidf_(x[3]); return r; }
__device__ __forceinline__ float gelu_tanh(float x) { const float z = 0.7978845608028654f * (x + 0.044715f * x * x * x); const float th = 1.0f - 2.0f * __builtin_amdgcn_rcpf(1.0f + __expf(2.0f * z)); return 0.5f * x * (1.0f + th); }
__device__ __forceinline__ int lane_id() { return (int)__builtin_amdgcn_mbcnt_hi(~0u, __builtin_amdgcn_mbcnt_lo(~0u, 0u)); }
__device__ __forceinline__ float wave_sum(float v) {
#pragma unroll
    for (int o = 1; o < 64; o <<= 1) v += __shfl_xor(v, o);
    return v;
}

namespace pg8 {
#define PG8_LAS __attribute__((address_space(3)))
typedef unsigned short bf16_t;
constexpr int BM = 256, BK = 64, HALF = 128, HTB = HALF * BK * 2  , STAGE_BYTES = 8 * HTB, NXCD = 8, WGM = 8;
__host__ __device__ __forceinline__ int lds_byte(int r, int c) { const int st = (r >> 4) * 2 + (c >> 5), rr = r & 15, cc = c & 31, ob = rr * 64 + cc * 2; return st * 1024 + (ob ^ (((ob >> 9) & 1) << 5)); }
__host__ __device__ __forceinline__ void stage_rc(int b, int& R, int& C) { const int st = b / 1024, sb = b % 1024, swz = sb ^ (((sb >> 9) & 1) << 5); R = (st >> 1) * 16 + swz / 64; C = (st & 1) * 32 + (swz % 64) / 2; }
__host__ __device__ __forceinline__ int perm32(int rho) { const int n = rho >> 4, i = rho & 15; return 8 * (i >> 2) + 4 * n + (i & 3); }

struct Unit { int pm, pn; long long aoff, boff; };
struct Gemm { const bf16_t* A; const bf16_t* Bt; int lda, ldb, K; };

__device__ __forceinline__ void static_unit(int L, int nM, int nN, int& pm, int& pn) {
    const int nwg = nM * nN; int wgid = L; { const int q = nwg / NXCD, r = nwg % NXCD, xcd = wgid % NXCD, off = wgid / NXCD; wgid = (xcd < r ? xcd * (q + 1) : r * (q + 1) + (xcd - r) * q) + off; }
    const int nig = WGM * nN, gid = wgid / nig, fm = gid * WGM, gsz = (nM - fm) < WGM ? (nM - fm) : WGM;
    pm = fm + ((wgid % nig) % gsz); pn = (wgid % nig) / gsz;
}
template <class Epi, class Sched, bool ALIGN_EPI = false, bool SP2 = false>
__device__ __forceinline__ void gemm_phase(PG8_LAS unsigned char* lds, const Gemm g, const Sched& S, const Epi& E, const int wave_id) {
    int lane_ = lane_id(); asm volatile("" : "+v"(lane_));
    const int wid = wave_id, lane = lane_, tid = wid * 64 + lane, wr = wid >> 2, wc = wid & 3, fr = lane & 15, fq = lane >> 4;
    const int K = g.K, nt = K / BK;
    unsigned voffA[2], voffB[2];
#pragma unroll
    for (int i = 0; i < 2; ++i) { int R, C; stage_rc(tid * 16 + i * 8192, R, C); const int Rb = Epi::PERM ? ((R & ~31) + perm32(R & 31)) : R;
        voffA[i] = (unsigned)(R * g.lda + C) * 2u; voffB[i] = (unsigned)(Rb * g.ldb + C) * 2u; }
    const size_t kstep = (size_t)(BK * 2);
    const size_t hstepA = (size_t)HALF * g.lda * 2, hstepB = (size_t)HALF * g.ldb * 2;
    const unsigned ldsw = (unsigned)wid * 1024u;
    const int aoff = lds_byte(wr * 64 + fr, fq * 8), boff = lds_byte(wc * 32 + fr, fq * 8);
#define PG8_SA(b, h) (((b) * 2 + (h)) * HTB)
#define PG8_SB(b, h) ((4 + (b) * 2 + (h)) * HTB)
#define PG8_STAGE(bufoff, gbase, voff) do { _Pragma("unroll") for (int _i = 0; _i < 2; ++_i) \
        __builtin_amdgcn_global_load_lds((const unsigned*)((const char*)(gbase) + (voff)[_i]), (PG8_LAS unsigned*)(lds + (bufoff) + ldsw + _i * 8192), 16, 0, 0); } while (0)
#define PG8_LDA(dst, b, h) do { _Pragma("unroll") for (int m = 0; m < 4; ++m) _Pragma("unroll") for (int k = 0; k < 2; ++k) dst[m][k] = *(const PG8_LAS bf16x8*)(lds + PG8_SA(b, h) + aoff + m * 2048 + k * 1024); } while (0)
#define PG8_LDB(dst, b, h) do { _Pragma("unroll") for (int n = 0; n < 2; ++n) _Pragma("unroll") for (int k = 0; k < 2; ++k) dst[n][k] = *(const PG8_LAS bf16x8*)(lds + PG8_SB(b, h) + boff + n * 2048 + k * 1024); } while (0)
#define PG8_MMA(ai, bj, At, Bt) do { __builtin_amdgcn_s_setprio(1); _Pragma("unroll") for (int m = 0; m < 4; ++m) _Pragma("unroll") for (int n = 0; n < 2; ++n) _Pragma("unroll") for (int k = 0; k < 2; ++k) \
        acc[ai][bj][m][n] = __builtin_amdgcn_mfma_f32_16x16x32_bf16(Bt[n][k], At[m][k], acc[ai][bj][m][n], 0, 0, 0); __builtin_amdgcn_s_setprio(0); } while (0)
#define PG8_WAIT_V(n) asm volatile("s_waitcnt vmcnt(" #n ")" ::: "memory")
#define PG8_WAIT_L(n) asm volatile("s_waitcnt lgkmcnt(" #n ")" ::: "memory")
#define PG8_BAR __builtin_amdgcn_s_barrier()
#define PG8_SCHED __builtin_amdgcn_sched_barrier(0)
    Unit cur, nxt; int ui = 0;
    if (!S.next(0, cur)) return;
    f32x4 acc[2][2][4][2];
#pragma unroll
    for (int a = 0; a < 2; ++a)
#pragma unroll
        for (int b = 0; b < 2; ++b)
#pragma unroll
            for (int m = 0; m < 4; ++m)
#pragma unroll
                for (int n = 0; n < 2; ++n) acc[a][b][m][n] = (f32x4){0.f, 0.f, 0.f, 0.f};
    bf16x8 At[4][2], B0[2][2], B1[2][2];
    const char* cA = (const char*)g.A + cur.aoff; const char* cB = (const char*)g.Bt + cur.boff;
    S.a_ready(cur);
    if constexpr (SP2) {
        PG8_STAGE(PG8_SB(0, 0), cB, voffB); PG8_STAGE(PG8_SB(0, 1), cB + hstepB, voffB); PG8_STAGE(PG8_SA(0, 0), cA, voffA); PG8_STAGE(PG8_SA(0, 1), cA + hstepA, voffA);
        if (wr == 1) PG8_BAR;
        PG8_WAIT_V(2); PG8_BAR;
        PG8_STAGE(PG8_SB(1, 0), cB + kstep, voffB); PG8_STAGE(PG8_SA(1, 0), cA + kstep, voffA); PG8_STAGE(PG8_SB(1, 1), cB + hstepB + kstep, voffB);
        PG8_WAIT_V(6); PG8_BAR;
    } else {
        PG8_STAGE(PG8_SB(0, 0), cB, voffB); PG8_STAGE(PG8_SA(0, 0), cA, voffA); PG8_STAGE(PG8_SB(0, 1), cB + hstepB, voffB); PG8_STAGE(PG8_SA(0, 1), cA + hstepA, voffA);
        if (wr == 1) PG8_BAR;
        PG8_WAIT_V(4); PG8_BAR;
        PG8_STAGE(PG8_SB(1, 0), cB + kstep, voffB); PG8_STAGE(PG8_SA(1, 0), cA + kstep, voffA); PG8_STAGE(PG8_SB(1, 1), cB + hstepB + kstep, voffB);
        PG8_WAIT_V(6); PG8_BAR;
    }
    for (;;) {
        const bool has_next = S.next(ui + 1, nxt);
        const char* nA = has_next ? (const char*)g.A + nxt.aoff : cA; const char* nB = has_next ? (const char*)g.Bt + nxt.boff : cB;
#pragma unroll 1
        for (int t = 0; t < nt; t += 2) {
            const bool last = (t == nt - 2);
            const char* a1 = cA + (size_t)(t + 1) * kstep;
            const char* a2 = last ? nA : cA + (size_t)(t + 2) * kstep; const char* b2 = last ? nB : cB + (size_t)(t + 2) * kstep;
            const char* a3 = a2 + kstep; const char* b3 = b2 + kstep;
            if (last && has_next) S.a_ready(nxt);
            if constexpr (SP2) {
            PG8_LDB(B0, 0, 0); PG8_LDB(B1, 0, 1); PG8_SCHED; PG8_LDA(At, 0, 0); PG8_STAGE(PG8_SA(1, 1), a1 + hstepA, voffA);
            PG8_WAIT_V(8); PG8_WAIT_L(0); PG8_BAR; PG8_MMA(0, 0, At, B0); PG8_MMA(0, 1, At, B1); PG8_BAR; PG8_SCHED;
            PG8_LDA(At, 0, 1); PG8_STAGE(PG8_SB(0, 0), b2, voffB); PG8_STAGE(PG8_SB(0, 1), b2 + hstepB, voffB); PG8_STAGE(PG8_SA(0, 0), a2, voffA);
            PG8_WAIT_V(8); PG8_WAIT_L(0); PG8_BAR; PG8_MMA(1, 0, At, B0); PG8_MMA(1, 1, At, B1); PG8_BAR; PG8_SCHED;
            PG8_LDB(B0, 1, 0); PG8_LDB(B1, 1, 1); PG8_SCHED; PG8_LDA(At, 1, 0); PG8_STAGE(PG8_SA(0, 1), a2 + hstepA, voffA);
            PG8_WAIT_V(8); PG8_WAIT_L(0); PG8_BAR; PG8_MMA(0, 0, At, B0); PG8_MMA(0, 1, At, B1); PG8_BAR; PG8_SCHED;
            PG8_LDA(At, 1, 1); PG8_STAGE(PG8_SB(1, 0), b3, voffB); PG8_STAGE(PG8_SB(1, 1), b3 + hstepB, voffB); PG8_STAGE(PG8_SA(1, 0), a3, voffA);
            PG8_WAIT_V(8); PG8_WAIT_L(0); PG8_BAR; PG8_MMA(1, 0, At, B0); PG8_MMA(1, 1, At, B1); PG8_BAR; PG8_SCHED;
            } else {
            PG8_LDB(B0, 0, 0); PG8_SCHED; PG8_LDA(At, 0, 0); PG8_STAGE(PG8_SA(1, 1), a1 + hstepA, voffA);
            PG8_WAIT_L(8); PG8_BAR; PG8_WAIT_L(0); PG8_MMA(0, 0, At, B0); PG8_BAR; PG8_SCHED;
            PG8_LDB(B1, 0, 1); PG8_STAGE(PG8_SB(0, 0), b2, voffB);
            PG8_BAR; PG8_WAIT_L(0); PG8_MMA(0, 1, At, B1); PG8_BAR;
            PG8_LDA(At, 0, 1); PG8_STAGE(PG8_SA(0, 0), a2, voffA);
            PG8_BAR; PG8_WAIT_L(0); PG8_MMA(1, 0, At, B0); PG8_BAR; PG8_SCHED;
            PG8_STAGE(PG8_SB(0, 1), b2 + hstepB, voffB);
            PG8_WAIT_V(6); PG8_BAR; PG8_MMA(1, 1, At, B1); PG8_BAR;
            PG8_LDB(B0, 1, 0); PG8_SCHED; PG8_LDA(At, 1, 0); PG8_STAGE(PG8_SA(0, 1), a2 + hstepA, voffA);
            PG8_WAIT_L(8); PG8_BAR; PG8_WAIT_L(0); PG8_MMA(0, 0, At, B0); PG8_BAR; PG8_SCHED;
            PG8_LDB(B1, 1, 1); PG8_STAGE(PG8_SB(1, 0), b3, voffB);
            PG8_BAR; PG8_WAIT_L(0); PG8_MMA(0, 1, At, B1); PG8_BAR;
            PG8_LDA(At, 1, 1); PG8_STAGE(PG8_SA(1, 0), a3, voffA);
            PG8_BAR; PG8_WAIT_L(0); PG8_MMA(1, 0, At, B0); PG8_BAR; PG8_SCHED;
            PG8_STAGE(PG8_SB(1, 1), b3 + hstepB, voffB);
            PG8_WAIT_V(6); PG8_BAR; PG8_MMA(1, 1, At, B1); PG8_BAR;
            }
        }
        if constexpr (ALIGN_EPI) { if (wr == 0) PG8_BAR; }
        if constexpr (!Epi::AFTER_DRAIN) { E(acc, cur, wr, wc, fr, fq); S.done(cur); }
        if (!has_next) break;
#pragma unroll
        for (int a = 0; a < 2; ++a)
#pragma unroll
            for (int b = 0; b < 2; ++b)
#pragma unroll
                for (int m = 0; m < 4; ++m)
#pragma unroll
                    for (int n = 0; n < 2; ++n) acc[a][b][m][n] = (f32x4){0.f, 0.f, 0.f, 0.f};
        cur = nxt; cA = nA; cB = nB; ++ui;
        if constexpr (ALIGN_EPI) { if (wr == 1) PG8_BAR; }
    }
    PG8_WAIT_V(0);
    if constexpr (!ALIGN_EPI) { if (wr == 0) PG8_BAR; }
    PG8_BAR;
    if constexpr (Epi::AFTER_DRAIN) { E.fused(acc, cur, wr, wc, fr, fq, lds, wid, lane); S.done(cur); }
#undef PG8_SA
#undef PG8_SB
#undef PG8_STAGE
#undef PG8_LDA
#undef PG8_LDB
#undef PG8_MMA
#undef PG8_WAIT_V
#undef PG8_WAIT_L
#undef PG8_BAR
#undef PG8_SCHED
}

}

using pg8::Unit; using pg8::Gemm;
typedef f32x4 Acc[2][2][4][2];

struct SchedBase { __device__ __forceinline__ void a_ready(const Unit&) const {} __device__ __forceinline__ void done(const Unit&) const {} };
struct SchedGrid : SchedBase { int nM, nN, G, c; long long atile, btile, acol, bbatch;
    __device__ __forceinline__ bool next(int i, Unit& u) const { const int L = i * G + c; if (L >= nM * nN) return false; pg8::static_unit(L, nM, nN, u.pm, u.pn);
        u.aoff = (long long)u.pm * atile + (long long)u.pn * acol; u.boff = (long long)u.pn * btile + (long long)(u.pm >> 5) * bbatch; return true; } };
struct SchedOne : SchedBase { Unit u0; bool have;
    __device__ __forceinline__ bool next(int i, Unit& u) const { if (i != 0 || !have) return false; u = u0; return true; } };
struct SchedMoe : SchedBase { volatile LAS int* tp; int G, c; long long atile, bexp, btile;
    __device__ __forceinline__ bool next(int i, Unit& u) const { const int L = i * G + c; const int nt4 = tp[32] * 4; if (L >= nt4) return false; const int tile = L >> 2; u.pm = tile; u.pn = L & 3;
        int e = 0;
#pragma unroll 1
        for (int k = 1; k < 32; ++k) e += (tp[k] <= tile) ? 1 : 0;
        u.aoff = (long long)tile * atile; u.boff = (long long)e * bexp + (long long)u.pn * btile; return true; } };

#define EPI_COMMON static constexpr bool PERM = true, AFTER_DRAIN = false;
struct EpiIn { EPI_COMMON bf16* V; bf16* UG;
    __device__ __forceinline__ void operator()(const Acc& acc, const Unit& u, int wr, int wc, int fr, int fq) const {
        const int row0 = u.pm * 256 + wr * 64 + fr;
        if (u.pn < 4) {
#pragma unroll
            for (int ai = 0; ai < 2; ++ai)
#pragma unroll
                for (int m = 0; m < 4; ++m) { const int row = row0 + ai * 128 + m * 16;
                    const f32x4 v0 = acc[ai][0][m][0] * sig4(acc[ai][1][m][0]), v1 = acc[ai][0][m][1] * sig4(acc[ai][1][m][1]);
                    *(u32x4*)(V + (size_t)row * 512 + u.pn * 128 + wc * 32 + 8 * fq) = pack8(v0, v1); }
        } else {
#pragma unroll
            for (int ai = 0; ai < 2; ++ai)
#pragma unroll
                for (int m = 0; m < 4; ++m) { const int row = row0 + ai * 128 + m * 16; const int b = row >> 13, chunk = (row >> 5) & 255, j = row & 31;
#pragma unroll
                    for (int bj = 0; bj < 2; ++bj) { const int cu = (u.pn - 4) * 256 + bj * 128 + wc * 32 + 8 * fq; const int g = cu >> 4, c0 = cu & 15;
                        *(u32x4*)(UG + ((size_t)((g * 2 + b) * 256 + chunk)) * KY + j * 16 + c0) = pack8(acc[ai][bj][m][0], acc[ai][bj][m][1]); } }
        }
    } };
struct EpiKV { EPI_COMMON bf16* KP; bf16* VT;
    __device__ __forceinline__ void operator()(const Acc& acc, const Unit& u, int wr, int wc, int fr, int fq) const {
        const int row0 = u.pm * 256 + wr * 64 + fr;
#pragma unroll
        for (int ai = 0; ai < 2; ++ai)
#pragma unroll
            for (int m = 0; m < 4; ++m) { const int row = row0 + ai * 128 + m * 16;
#pragma unroll
                for (int bj = 0; bj < 2; ++bj) { const int col = bj * 128 + wc * 32 + 8 * fq;
                    if (u.pn < 4) *(u32x4*)(KP + (size_t)row * 1024 + u.pn * 256 + col) = pack8(acc[ai][bj][m][0], acc[ai][bj][m][1]);
                    else { const int b = row >> 8, key = row & 255, h = u.pn - 4; bf16* vt = VT + ((size_t)(b * 4 + h) * 256 + col) * 256 + key;
#pragma unroll
                        for (int n = 0; n < 2; ++n)
#pragma unroll
                            for (int e = 0; e < 4; ++e) vt[(n * 4 + e) * 256] = (bf16)f2bf(acc[ai][bj][m][n][e]); } } }
    } };
struct EpiScan { static constexpr bool PERM = true, AFTER_DRAIN = true; bf16* UG; const float* Are; const float* Aim; const float* logdt;
    __device__ __forceinline__ void fused(const Acc& acc, const Unit& u, int wr, int wc, int fr, int fq, LAS unsigned char* lds, int wid, int lane) const {
        LAS float* El = (LAS float*)lds;
#pragma unroll
        for (int ai = 0; ai < 2; ++ai)
#pragma unroll
            for (int m = 0; m < 4; ++m) { const int row = ai * 128 + wr * 64 + m * 16 + fr;
#pragma unroll
                for (int n = 0; n < 2; ++n) { const int cc = (wc * 32 + 8 * fq + 4 * n) >> 2; *(LAS f32x4*)(El + row * 128 + ((cc ^ (row & 31)) << 2)) = acc[ai][0][m][n]; } }
        __syncthreads();
        if (wid == 0) {
            const int g = u.pm >> 1, p = lane;
            const double dt = exp((double)logdt[g]); const double lr = (double)Are[g * NP + p] * dt * CH, li = (double)Aim[g * NP + p] * dt * CH;
            const double mag = exp(lr); double sn, cs; sincos(li, &sn, &cs);
            const float ar = (float)(mag * cs), aim = (float)(mag * sn);
            float sr = 0.f, si = 0.f;
            bf16* ug = UG + (size_t)u.pm * 256 * KY + KE;
#pragma unroll 4
            for (int ch = 0; ch < NCH; ++ch) {
                ug[(size_t)ch * KY + p] = (bf16)f2bf(sr); ug[(size_t)ch * KY + NP + p] = (bf16)f2bf(si);
                const int sw = ch & 31; const float er = El[ch * 128 + ((((p >> 2) ^ sw) << 2) | (p & 3))], ei = El[ch * 128 + (((((64 + p) >> 2) ^ sw) << 2) | (p & 3))];
                const float nr = ar * sr - aim * si + er, ni = ar * si + aim * sr + ei; sr = nr; si = ni;
            }
        }
    } };
struct EpiY { EPI_COMMON const bf16* UG; const float* Dv; bf16* Gb;
    __device__ __forceinline__ void operator()(const Acc& acc, const Unit& u, int wr, int wc, int fr, int fq) const {
        const int g = u.pm >> 1, b = u.pm & 1, i = u.pn * 16 + 4 * wc + fq;
        f32x4 dv[4];
#pragma unroll
        for (int k = 0; k < 4; ++k) dv[k] = *(const f32x4*)(Dv + g * 16 + 4 * k);
#pragma unroll
        for (int ai = 0; ai < 2; ++ai)
#pragma unroll
            for (int m = 0; m < 4; ++m) { const int chunk = ai * 128 + wr * 64 + m * 16 + fr;
                const u32x4* up = (const u32x4*)(UG + ((size_t)u.pm * 256 + chunk) * KY + i * 16);
                const size_t t = (size_t)b * SEQ + chunk * CH + i;
#pragma unroll
                for (int bj = 0; bj < 2; ++bj) { const u32x4 uw = up[bj]; f32x4 y0 = acc[ai][bj][m][0], y1 = acc[ai][bj][m][1];
                    y0[0] += dv[2 * bj][0] * bflo(uw.x); y0[1] += dv[2 * bj][1] * bfhi(uw.x); y0[2] += dv[2 * bj][2] * bflo(uw.y); y0[3] += dv[2 * bj][3] * bfhi(uw.y);
                    y1[0] += dv[2 * bj + 1][0] * bflo(uw.z); y1[1] += dv[2 * bj + 1][1] * bfhi(uw.z); y1[2] += dv[2 * bj + 1][2] * bflo(uw.w); y1[3] += dv[2 * bj + 1][3] * bfhi(uw.w);
#pragma unroll
                    for (int e = 0; e < 4; ++e) { y0[e] = gelu_tanh(y0[e]); y1[e] = gelu_tanh(y1[e]); }
                    *(u32x4*)(Gb + t * 512 + g * 16 + bj * 8) = pack8(y0, y1); } }
    } };
template <int MODE> struct EpiPair { EPI_COMMON bf16* O; int ld, coloff;
    __device__ __forceinline__ void operator()(const Acc& acc, const Unit& u, int wr, int wc, int fr, int fq) const {
        const int row0 = u.pm * 256 + wr * 64 + fr;
#pragma unroll
        for (int ai = 0; ai < 2; ++ai)
#pragma unroll
            for (int m = 0; m < 4; ++m) { const int row = row0 + ai * 128 + m * 16; f32x4 v0, v1;
                if (MODE == 0) { v0 = acc[ai][0][m][0] * sig4(acc[ai][1][m][0]); v1 = acc[ai][0][m][1] * sig4(acc[ai][1][m][1]); }
                else { v0 = acc[ai][0][m][0] * sig4(acc[ai][0][m][0]) * acc[ai][1][m][0]; v1 = acc[ai][0][m][1] * sig4(acc[ai][0][m][1]) * acc[ai][1][m][1]; }
                *(u32x4*)(O + (size_t)row * ld + coloff + u.pn * 128 + wc * 32 + 8 * fq) = pack8(v0, v1); }
    } };
struct EpiH1 { EPI_COMMON const float* X; float* OUT; bf16* H1B; float* RS1;
    __device__ __forceinline__ void operator()(const Acc& acc, const Unit& u, int wr, int wc, int fr, int fq) const {
        const int row0 = u.pm * 256 + wr * 64 + fr;
#pragma unroll
        for (int ai = 0; ai < 2; ++ai)
#pragma unroll
            for (int m = 0; m < 4; ++m) { const int row = row0 + ai * 128 + m * 16; float ss = 0.f;
#pragma unroll
                for (int bj = 0; bj < 2; ++bj) { const size_t o = (size_t)row * 1024 + u.pn * 256 + bj * 128 + wc * 32 + 8 * fq;
                    const f32x4 h0 = *(const f32x4*)(X + o) + acc[ai][bj][m][0], h1 = *(const f32x4*)(X + o + 4) + acc[ai][bj][m][1];
                    *(f32x4*)(OUT + o) = h0; *(f32x4*)(OUT + o + 4) = h1; *(u32x4*)(H1B + o) = pack8(h0, h1);
                    ss += (h0[0] * h0[0] + h0[1] * h0[1]) + (h0[2] * h0[2] + h0[3] * h0[3]) + (h1[0] * h1[0] + h1[1] * h1[1]) + (h1[2] * h1[2] + h1[3] * h1[3]); }
                ss += __shfl_xor(ss, 16); ss += __shfl_xor(ss, 32);
                if (fq == 0) RS1[(size_t)row * 16 + u.pn * 4 + wc] = ss; }
    } };
struct EpiQ { EPI_COMMON bf16* Q; const LAS float* rl;
    __device__ __forceinline__ void operator()(const Acc& acc, const Unit& u, int wr, int wc, int fr, int fq) const {
#pragma unroll
        for (int ai = 0; ai < 2; ++ai)
#pragma unroll
            for (int m = 0; m < 4; ++m) { const int rloc = ai * 128 + wr * 64 + m * 16 + fr; const float s = rl[rloc] * 0.0625f; const size_t row = (size_t)u.pm * 256 + rloc;
#pragma unroll
                for (int bj = 0; bj < 2; ++bj) *(u32x4*)(Q + row * 1024 + u.pn * 256 + bj * 128 + wc * 32 + 8 * fq) = pack8(acc[ai][bj][m][0] * s, acc[ai][bj][m][1] * s); }
    } };
struct EpiSm { static constexpr bool PERM = true, AFTER_DRAIN = true; bf16* P; const LAS float* rl;
    __device__ __forceinline__ void fused(Acc& acc, const Unit& u, int wr, int wc, int fr, int fq, LAS unsigned char* lds, int wid, int lane) const {
        LAS float* Xm = (LAS float*)lds; LAS float* Xs = Xm + 1024;
#pragma unroll
        for (int ai = 0; ai < 2; ++ai)
#pragma unroll
            for (int m = 0; m < 4; ++m) { float v = -3.0e38f; const float sc = rl[ai * 128 + wr * 64 + m * 16 + fr] * 0.0625f;
#pragma unroll
                for (int bj = 0; bj < 2; ++bj)
#pragma unroll
                    for (int n = 0; n < 2; ++n)
#pragma unroll
                        for (int e = 0; e < 4; ++e) { acc[ai][bj][m][n][e] *= sc; v = fmaxf(v, acc[ai][bj][m][n][e]); }
                v = fmaxf(v, __shfl_xor(v, 16)); v = fmaxf(v, __shfl_xor(v, 32));
                if (fq == 0) Xm[(ai * 128 + wr * 64 + m * 16 + fr) * 4 + wc] = v; }
        __syncthreads();
#pragma unroll
        for (int ai = 0; ai < 2; ++ai)
#pragma unroll
            for (int m = 0; m < 4; ++m) { const f32x4 q = *(const LAS f32x4*)(Xm + (ai * 128 + wr * 64 + m * 16 + fr) * 4); const float rm = fmaxf(fmaxf(q[0], q[1]), fmaxf(q[2], q[3])); float s = 0.f;
#pragma unroll
                for (int bj = 0; bj < 2; ++bj)
#pragma unroll
                    for (int n = 0; n < 2; ++n)
#pragma unroll
                        for (int e = 0; e < 4; ++e) { const float pe = __expf(acc[ai][bj][m][n][e] - rm); acc[ai][bj][m][n][e] = pe; s += pe; }
                s += __shfl_xor(s, 16); s += __shfl_xor(s, 32);
                if (fq == 0) Xs[(ai * 128 + wr * 64 + m * 16 + fr) * 4 + wc] = s; }
        __syncthreads();
#pragma unroll
        for (int ai = 0; ai < 2; ++ai)
#pragma unroll
            for (int m = 0; m < 4; ++m) { const int rloc = ai * 128 + wr * 64 + m * 16 + fr; const f32x4 q = *(const LAS f32x4*)(Xs + rloc * 4); const float inv = __builtin_amdgcn_rcpf((q[0] + q[1]) + (q[2] + q[3]));
                const size_t row = (size_t)u.pm * 256 + rloc;
#pragma unroll
                for (int bj = 0; bj < 2; ++bj) *(u32x4*)(P + row * 1024 + u.pn * 256 + bj * 128 + wc * 32 + 8 * fq) = pack8(acc[ai][bj][m][0] * inv, acc[ai][bj][m][1] * inv); }
    } };
struct EpiBf { EPI_COMMON bf16* O; int ld;
    __device__ __forceinline__ void operator()(const Acc& acc, const Unit& u, int wr, int wc, int fr, int fq) const {
        const int row0 = u.pm * 256 + wr * 64 + fr;
#pragma unroll
        for (int ai = 0; ai < 2; ++ai)
#pragma unroll
            for (int m = 0; m < 4; ++m) { const int row = row0 + ai * 128 + m * 16;
#pragma unroll
                for (int bj = 0; bj < 2; ++bj) *(u32x4*)(O + (size_t)row * ld + u.pn * 256 + bj * 128 + wc * 32 + 8 * fq) = pack8(acc[ai][bj][m][0], acc[ai][bj][m][1]); }
    } };
struct EpiH2 { EPI_COMMON float* OUT;
    __device__ __forceinline__ void operator()(const Acc& acc, const Unit& u, int wr, int wc, int fr, int fq) const {
        const int row0 = u.pm * 256 + wr * 64 + fr;
#pragma unroll
        for (int ai = 0; ai < 2; ++ai)
#pragma unroll
            for (int m = 0; m < 4; ++m) { const int row = row0 + ai * 128 + m * 16;
#pragma unroll
                for (int bj = 0; bj < 2; ++bj) { float* o = OUT + (size_t)row * 1024 + u.pn * 256 + bj * 128 + wc * 32 + 8 * fq;
                    const f32x4 h0 = *(const f32x4*)o + acc[ai][bj][m][0], h1 = *(const f32x4*)(o + 4) + acc[ai][bj][m][1]; *(f32x4*)o = h0; *(f32x4*)(o + 4) = h1; } }
    } };
struct EpiDown { EPI_COMMON bf16* Y; const float* gate;
    __device__ __forceinline__ void operator()(const Acc& acc, const Unit& u, int wr, int wc, int fr, int fq) const {
        const int row0 = u.pm * 256 + wr * 64 + fr;
#pragma unroll
        for (int ai = 0; ai < 2; ++ai)
#pragma unroll
            for (int m = 0; m < 4; ++m) { const int row = row0 + ai * 128 + m * 16; const float gt = gate[row];
#pragma unroll
                for (int bj = 0; bj < 2; ++bj) *(u32x4*)(Y + (size_t)row * 1024 + u.pn * 256 + bj * 128 + wc * 32 + 8 * fq) = pack8(acc[ai][bj][m][0] * gt, acc[ai][bj][m][1] * gt); }
    } };

#define XB_TMO      128
#define XB_XCNT(j)  (256  + 64 * (j))
#define XB_XSUB(j)  (1280 + 64 * (j))
#define XB_XGEN(j)  (2304 + 64 * (j))
#define XB_TOP      3328
#define XB_TOPGEN   3392
#define XCD_BAR_WORDS 3456
#define XB_SPIN_CAP (1u << 18)

__device__ __forceinline__ unsigned xb_ld(unsigned* p)              { return __hip_atomic_load(p, __ATOMIC_RELAXED, __HIP_MEMORY_SCOPE_AGENT); }
__device__ __forceinline__ unsigned xb_add(unsigned* p, unsigned v) { return __hip_atomic_fetch_add(p, v, __ATOMIC_RELAXED, __HIP_MEMORY_SCOPE_AGENT); }
__device__ __forceinline__ unsigned xb_xcc_id() { return (unsigned)__builtin_amdgcn_s_getreg((3 << 11) | 20) & 0xFu; }
#define XB_SPIN(cond, bar) do { unsigned _sp = 0; while (cond) { __builtin_amdgcn_s_sleep(1); \
    if ((++_sp & 255u) == 0u) { if (xb_ld(&(bar)[XB_TMO])) break; if (_sp > XB_SPIN_CAP) { atomicAdd(&(bar)[XB_TMO], 1u); break; } } } } while (0)

struct XcdBarrier {
    unsigned* bar; unsigned x;
    unsigned w0;
    volatile LAS unsigned* st;
};

__device__ __forceinline__ XcdBarrier xcd_barrier_post(unsigned* bar, volatile LAS unsigned* st) {
    XcdBarrier b; b.bar = bar; b.x = xb_xcc_id(); b.st = st; b.w0 = (__builtin_amdgcn_readfirstlane((int)threadIdx.x >> 6) == 0) ? 1u : 0u;
    if (threadIdx.x == 0) (void)xb_add(&bar[XB_XCNT(b.x)], 1u);
    return b;
}
__device__ __forceinline__ void xcd_barrier_complete(unsigned* bar, unsigned x, unsigned& nloc, unsigned& nx) {
    const unsigned G = gridDim.x * gridDim.y * gridDim.z;
    unsigned sum, cnt, mine, sp = 0u;
    for (;;) {
        sum = 0u; cnt = 0u; mine = 0u;
#pragma unroll
        for (unsigned j = 0; j < 16; ++j) { const unsigned c = xb_ld(&bar[XB_XCNT(j)]); sum += c; cnt += (c > 0u) ? 1u : 0u; mine = (j == x) ? c : mine; }
        if (sum == G) break;
        __builtin_amdgcn_s_sleep(1);
        if ((++sp & 255u) == 0u) { if (xb_ld(&bar[XB_TMO])) break; if (sp > XB_SPIN_CAP) { atomicAdd(&bar[XB_TMO], 1u); break; } }
    }
    nloc = mine > 0u ? mine : 1u; nx = cnt > 0u ? cnt : 1u;
}

__device__ __forceinline__ void xcd_barrier(const XcdBarrier& b) {
    asm volatile("s_waitcnt vmcnt(0)" ::: "memory");
    __syncthreads();
    if (b.w0 && lane_id() == 0) {
        unsigned* bar = b.bar;
        __builtin_amdgcn_s_waitcnt(0);
        unsigned nloc = b.st[0], nx = b.st[1];
        if (nloc == 0u) { xcd_barrier_complete(bar, b.x, nloc, nx); b.st[0] = nloc; b.st[1] = nx; }
        const unsigned old = xb_add(&bar[XB_XSUB(b.x)], 1u);
        const unsigned gen = old / nloc;
        if (old + 1u == (gen + 1u) * nloc) {
            __builtin_amdgcn_fence(__ATOMIC_RELEASE, "agent");
            asm volatile("s_waitcnt vmcnt(0)" ::: "memory");
            const unsigned og = xb_add(&bar[XB_TOP], 1u);
            const unsigned tg = og / nx;
            if (og + 1u == (tg + 1u) * nx) xb_add(&bar[XB_TOPGEN], 1u);
            else XB_SPIN(xb_ld(&bar[XB_TOPGEN]) == tg, bar);
            __builtin_amdgcn_fence(__ATOMIC_ACQUIRE, "agent");
            xb_add(&bar[XB_XGEN(b.x)], 1u);
            asm volatile("s_waitcnt vmcnt(0)" ::: "memory");
        } else {
            XB_SPIN(xb_ld(&bar[XB_XGEN(b.x)]) == gen, bar);
            __builtin_amdgcn_fence(__ATOMIC_ACQUIRE, "agent");
            asm volatile("s_waitcnt vmcnt(0)" ::: "memory");
        }
    }
    __syncthreads();
}

__device__ __forceinline__ void tr_load(float (&v)[32], const float* W, int ldw, int k0, int n0, const float* kscale, int lane) {
#pragma unroll
    for (int i = 0; i < 32; ++i) { const int kk = 2 * i + (lane >> 5); v[i] = W[(size_t)(k0 + kk) * ldw + n0 + (lane & 31)]; }
    if (kscale) {
#pragma unroll
        for (int i = 0; i < 32; ++i) v[i] *= kscale[k0 + 2 * i + (lane >> 5)]; }
}
__device__ __forceinline__ void tr_finish(const float (&v)[32], bf16* WT, int ldwt, int k0, int dst_row0, LAS float* scr, int lane) {
#pragma unroll
    for (int i = 0; i < 32; ++i) scr[(2 * i + (lane >> 5)) * 33 + (lane & 31)] = v[i];
    LDS_WAIT(); asm volatile("" ::: "memory");
    const int c = lane & 7;
#pragma unroll
    for (int j = 0; j < 4; ++j) { const int n = (lane >> 3) + 8 * j; const LAS float* s = scr + (8 * c) * 33 + n;
        u32x4 o; o.x = pk2(s[0 * 33], s[1 * 33]); o.y = pk2(s[2 * 33], s[3 * 33]); o.z = pk2(s[4 * 33], s[5 * 33]); o.w = pk2(s[6 * 33], s[7 * 33]);
        *(u32x4*)(WT + (size_t)(dst_row0 + n) * ldwt + k0 + 8 * c) = o; }
    LDS_WAIT(); asm volatile("" ::: "memory");
}
__device__ __forceinline__ void transpose_item(const float* W, int ldw, bf16* WT, int ldwt, int k0, int n0, int dst_row0, const float* kscale, LAS float* scr, int lane) {
    float v[32]; tr_load(v, W, ldw, k0, n0, kscale, lane); tr_finish(v, WT, ldwt, k0, dst_row0, scr, lane);
}
__device__ __forceinline__ void rms_row_to_bf16(const float* xrow, const float* gain, bf16* orow, int lane) {
    f32x4 v[4]; float s = 0.f;
#pragma unroll
    for (int j = 0; j < 4; ++j) { v[j] = *(const f32x4*)(xrow + (lane + 64 * j) * 4); s += (v[j][0] * v[j][0] + v[j][1] * v[j][1]) + (v[j][2] * v[j][2] + v[j][3] * v[j][3]); }
    const float r = 1.0f / sqrtf(wave_sum(s) * (1.f / D) + EPS);
#pragma unroll
    for (int j = 0; j < 4; ++j) { const f32x4 gn = *(const f32x4*)(gain + (lane + 64 * j) * 4); u32x2 o; o.x = pk2(v[j][0] * r * gn[0], v[j][1] * r * gn[1]); o.y = pk2(v[j][2] * r * gn[2], v[j][3] * r * gn[3]);
        *(u32x2*)(orow + (lane + 64 * j) * 4) = o; }
}
__device__ __forceinline__ void ssm_consts(const float* Are, const float* Aim, const float* logdt, int g, int p, double& lr, double& li, double& cr, double& ci) {
    const double dt = exp((double)logdt[g]), a = (double)Are[g * NP + p], b = (double)Aim[g * NP + p];
    lr = a * dt; li = b * dt;
    const double mag = exp(lr); double sn, cs; sincos(li, &sn, &cs);
    const double x = mag * cs - 1.0, y = mag * sn, den = a * a + b * b;
    cr = (x * a + y * b) / den; ci = (y * a - x * b) / den;
}
__device__ __forceinline__ void cpow_d(double lr, double li, int m, float& zr, float& zi) { const double mag = exp(lr * m); double sn, cs; sincos(li * m, &sn, &cs); zr = (float)(mag * cs); zi = (float)(mag * sn); }

struct Args { const float* in[33]; float* out; unsigned char* ws; int ph_lo, ph_hi; };


constexpr int NITEMS_MOE = NE * 768;
constexpr int CW_QHEAD = 64;
#define CW_DONE(k) (128 + 64 * (k))
struct MoeIt { const float* src; bf16* dst; int ldw, ldwt, k0, n0, drow; };
__device__ __forceinline__ MoeIt moe_decode(int r, const float* w1, const float* w3, const float* w2, bf16* WUP, bf16* WDN) {
    const int e = r / 768, q = r % 768; MoeIt m;
    if (q < 512) { const int which = q >> 8, qq = q & 255, kb = qq >> 4, n0 = (qq & 15) * 32;
        m.src = (which ? w3 : w1) + (size_t)e * 1024 * 512; m.ldw = 512; m.dst = WUP + (size_t)e * 1024 * 1024; m.ldwt = 1024; m.k0 = kb * 64; m.n0 = n0; m.drow = (n0 >> 7) * 256 + which * 128 + (n0 & 127); }
    else { const int qq = q - 512, kb = qq >> 5, n0 = (qq & 31) * 32;
        m.src = w2 + (size_t)e * 512 * 1024; m.ldw = 1024; m.dst = WDN + (size_t)e * 1024 * 512; m.ldwt = 512; m.k0 = kb * 64; m.n0 = n0; m.drow = n0; }
    return m;
}
__device__ __forceinline__ void idle_convert(unsigned* ctl, int phase, int G, bool use_done, const float* w1, const float* w3, const float* w2, bf16* WUP, bf16* WDN, LAS unsigned char* lds, int wave, int lane, int tid) {
    volatile LAS int* bc = (volatile LAS int*)(lds + LCTL_OFF + 64);
    LAS float* scr = (LAS float*)(lds + wave * 17408);
    asm volatile("s_waitcnt vmcnt(0)" ::: "memory");
    __syncthreads();
    if (use_done && tid == 0) (void)xb_add(&ctl[CW_DONE(phase)], 1u);
    for (;;) {
        if (tid == 0) { int base = NITEMS_MOE; const bool stop = use_done && (xb_ld(&ctl[CW_DONE(phase)]) >= (unsigned)G); if (!stop) base = (int)xb_add(&ctl[CW_QHEAD], 16u); bc[0] = base; }
        __syncthreads();
        const int base = bc[0];
        __syncthreads();
        if (base >= NITEMS_MOE) break;
        const MoeIt a = moe_decode(base + 2 * wave, w1, w3, w2, WUP, WDN), b = moe_decode(base + 2 * wave + 1, w1, w3, w2, WUP, WDN);
        float va[32], vb[32];
        tr_load(va, a.src, a.ldw, a.k0, a.n0, nullptr, lane); tr_load(vb, b.src, b.ldw, b.k0, b.n0, nullptr, lane);
        tr_finish(va, a.dst, a.ldwt, a.k0, a.drow, scr, lane); tr_finish(vb, b.dst, b.ldwt, b.k0, b.drow, scr + 2176, lane);
    }
}

template <int NS> __device__ __forceinline__ void conv_block(float (&win)[CWID], const float (&w)[CWID], const bf16* vcol, float bias, LAS float* outl) {
#pragma unroll
    for (int ss = 0; ss < NS; ++ss) {
        win[ss % CWID] = bf2f(vcol[(size_t)ss * 512]);
        float a = bias;
#pragma unroll
        for (int k = 0; k < CWID; ++k) a += w[k] * win[(ss + k + 1) % CWID];
        outl[ss * 512] = a;
    }
}

__device__ __forceinline__ int toep_col(int i, int c) { return (i >> 4) * 256 + (c >> 3) * 128 + (i & 15) * 8 + (c & 7); }


#define X (args.in[0])
#define OUT (args.out)
#define WSP(T_, off) ((T_*)(ws + (off)))
#define WIN_T WSP(bf16, WS_WIN)
#define WOUT_T WSP(bf16, WS_WOUT)
#define WQN WSP(bf16, WS_WQ)
#define WKV_T WSP(bf16, WS_WKV)
#define WO_T WSP(bf16, WS_WO)
#define TOEP WSP(bf16, WS_TOEP)
#define ETAB WSP(bf16, WS_ETAB)
#define GLUBT WSP(bf16, WS_GLUBT)
#define MEMN WSP(bf16, WS_MEMN)
#define KVP WSP(bf16, WS_KVP)
#define QKT WSP(bf16, WS_QKT)
#define VWOT WSP(bf16, WS_VWOT)
#define WUP_T WSP(bf16, WS_WUP)
#define WDN_T WSP(bf16, WS_WDN)
#define HN WSP(bf16, WS_HN)
#define VBUF WSP(bf16, WS_VBUF)
#define UG WSP(bf16, WS_UG)
#define CONCAT WSP(bf16, WS_CONCAT)
#define GB WSP(bf16, WS_G)
#define H1B WSP(bf16, WS_H1B)
#define PBUF WSP(bf16, WS_PBUF)
#define XG WSP(bf16, WS_XG)
#define HID WSP(bf16, WS_HID)
#define HIST WSP(int, WS_HIST)
#define TPREF WSP(int, WS_TPREF)
#define TOKE WSP(int, WS_TOKE)
#define TOKG WSP(float, WS_TOKG)
#define TOKS WSP(int, WS_TOKS)
#define RSTD3 WSP(float, WS_RSTD3)
#define SGATE WSP(float, WS_SGATE)
#define RS1 WSP(float, WS_RS1)
#define WRH WSP(bf16, WS_W36)
#define WRL WSP(bf16, WS_W36 + 48 * 1024 * 2)
#define SSMC WSP(float, WS_KMAT)
__global__ void __launch_bounds__(NTHR, 2) mk_fwd(Args args) {
    extern __shared__ __attribute__((aligned(16))) unsigned char lds_raw[];
    LAS unsigned char* lds = (LAS unsigned char*)lds_raw;
    const int wave = __builtin_amdgcn_readfirstlane((int)threadIdx.x >> 6);
#define PH_IDS int lane = lane_id(); asm volatile("" : "+v"(lane)); const int tid = wave * 64 + lane
    const int G = gridDim.x, c = blockIdx.x;
    const int vcu = (G % 8 == 0) ? (c % 8) * (G / 8) + c / 8 : c;
    const int gw = vcu * NWAVES + wave, NGW = G * NWAVES;
    unsigned char* ws = args.ws;
    volatile LAS unsigned* LCTL = (volatile LAS unsigned*)(lds + LCTL_OFF);
    { PH_IDS; for (int u = tid; u < 128; u += NTHR) LCTL[u] = 0u; }
    __syncthreads();
    XcdBarrier bar; bar.bar = (unsigned*)(ws + WS_CTL) + CW_BAR; bar.x = 0; bar.st = nullptr; bar.w0 = 0;
    if (!MK_PER_PHASE) bar = xcd_barrier_post((unsigned*)(ws + WS_CTL) + CW_BAR, LCTL + 8);
#define GRID_BAR() do { if (!MK_PER_PHASE) xcd_barrier(bar); } while (0)
    const int lo = args.ph_lo, hi = args.ph_hi;
#ifndef PH_MASK
#define PH_MASK 0x1fff
#endif
#define IN(k) (((PH_MASK >> (k)) & 1) && lo <= (k) && (k) < hi)
#define BOTH(k) (IN(k) && IN((k) + 1))
#define PHASE(k) if (IN(k))

    PHASE(0) {
        PH_IDS; (void)tid;
        const int gt = gw * 64 + lane, NGT = NGW * 64;
        for (int idx = gt; idx < NG * NP; idx += NGT) { const int g = idx >> 6, p = idx & 63; double lr, li, cr, ci; ssm_consts(args.in[8], args.in[9], args.in[10], g, p, lr, li, cr, ci);
            float ar, ai; cpow_d(lr, li, 1, ar, ai); float* o = SSMC + (size_t)idx * 8; o[0] = (float)lr; o[1] = (float)li; o[2] = (float)cr; o[3] = (float)ci; o[4] = ar; o[5] = ai; o[6] = 0.f; o[7] = 0.f; }
        for (int idx = gt; idx < 4 * 256 * 128; idx += NGT) { const int pn = idx >> 15, np = (idx >> 7) & 255, k = idx & 127; const int bj = np >> 7, gl = (np >> 4) & 7, e = np & 15; const int g = pn * 8 + gl;
            const float v = ((k >> 4) == gl) ? args.in[16][(size_t)(g * 16 + (k & 15)) * 32 + bj * 16 + e] : 0.f; GLUBT[idx] = (bf16)f2bf(v); }
        for (int idx = gt; idx < 48 * D; idx += NGT) { const int q = idx >> 10, k = idx & 1023; const float w = (q < NCOLR) ? args.in[24][k] * (q < 4 ? args.in[25][k * 4 + q] : args.in[27][k * 32 + q - 4]) : 0.f;
            const unsigned hb = f2bf(w); WRH[idx] = (bf16)hb; WRL[idx] = (bf16)f2bf(w - bf2f(hb)); }
        for (int idx = gt; idx < D * D / 8; idx += NGT) { const int kin = idx >> 7, o8 = (idx & 127) * 8; const float gn = args.in[18][kin]; const float* s = args.in[20] + (size_t)kin * D + o8;
            *(u32x4*)(WQN + (size_t)kin * D + o8) = pack8(*(const f32x4*)s * gn, *(const f32x4*)(s + 4) * gn); }
        for (int m = gw; m < T; m += NGW) rms_row_to_bf16(X + (size_t)m * D, args.in[2], HN + (size_t)m * D, lane);
        for (int m = gw; m < TM; m += NGW) rms_row_to_bf16(args.in[1] + (size_t)m * D, args.in[19], MEMN + (size_t)m * D, lane);
        LAS float* scr = (LAS float*)(lds + wave * 16384);
        constexpr int I_IN = 16 * 48, I_SQ = 16 * 32, NITEMS = I_IN + 4 * I_SQ;
        for (int it = gw; it < NITEMS; it += NGW) {
            int r = it;
            if (r < I_IN) { const int kb = r / 48, nb = r % 48, n0 = nb * 32; const int dst = (n0 < 1024) ? (((n0 & 511) >> 7) * 256 + (n0 >> 9) * 128 + (n0 & 127)) : n0;
                transpose_item(args.in[3], 1536, WIN_T, 1024, kb * 64, n0, dst, nullptr, scr, lane); continue; } r -= I_IN;
            if (r < 4 * I_SQ) { const int w = r / I_SQ, q = r % I_SQ, kb = q / 32, n0 = (q % 32) * 32;
                const float* src = (w == 0) ? args.in[17] : (w == 1) ? args.in[21] : (w == 2) ? args.in[22] : args.in[23];
                bf16* dstp = (w == 0) ? WOUT_T : (w == 1) ? WKV_T : (w == 2) ? WKV_T + (size_t)1024 * 1024 : WO_T;
                transpose_item(src, 1024, dstp, 1024, kb * 64, n0, n0, nullptr, scr, lane); continue; }
        }
        if (BOTH(0)) GRID_BAR();
    }

    PHASE(1) {
        PH_IDS; (void)tid;
        { Gemm g{HN, WIN_T, 1024, 1024, 1024}; SchedGrid S; S.nM = 64; S.nN = 6; S.G = G; S.c = c; S.atile = 256ll * 1024 * 2; S.btile = 256ll * 1024 * 2; S.acol = 0; S.bbatch = 0;
          EpiIn E{VBUF, UG}; pg8::gemm_phase<EpiIn, SchedGrid, true, true>(lds, g, S, E, wave); }
        if (c >= 128) {
            if (c < 144) { Gemm g{MEMN, WKV_T, 1024, 1024, 1024}; SchedOne S; const int L = c - 128; S.have = true; S.u0.pm = L >> 3; S.u0.pn = L & 7; S.u0.aoff = (long long)(L >> 3) * 256 * 1024 * 2; S.u0.boff = (long long)(L & 7) * 256 * 1024 * 2;
                EpiBf E{KVP, 2048}; pg8::gemm_phase<EpiBf, SchedOne, true, true>(lds, g, S, E, wave); }
            if (c >= 144) {
            const int sidx = (c - 144) * NTHR + tid, NS = 112 * NTHR;
            const float* Bre = args.in[11]; const float* Bim = args.in[12]; const float* Cre = args.in[13]; const float* Cim = args.in[14];
            for (int idx = sidx - 32768; idx >= 0 && idx < NG * 128; idx += NS) { const int g = idx >> 7, q = idx & 127, p = q & 63; const float* sc = SSMC + (size_t)(g * NP + p) * 8;
                float zr = sc[2], zi = sc[3]; const float ar = sc[4], ai = sc[5];
                f32x4 br[4], bi[4];
#pragma unroll
                for (int k = 0; k < 4; ++k) { br[k] = *(const f32x4*)(Bre + (size_t)(g * NP + p) * 16 + 4 * k); bi[k] = *(const f32x4*)(Bim + (size_t)(g * NP + p) * 16 + 4 * k); }
                for (int j = CH - 1; j >= 0; --j) { f32x4 o[4];
#pragma unroll
                    for (int k = 0; k < 4; ++k) o[k] = (q < 64) ? (br[k] * zr - bi[k] * zi) : (bi[k] * zr + br[k] * zi);
                    bf16* d = ETAB + (size_t)(g * 128 + q) * KE + j * 16; *(u32x4*)d = pack8(o[0], o[1]); *(u32x4*)(d + 8) = pack8(o[2], o[3]);
                    const float t = zr * ar - zi * ai; zi = zr * ai + zi * ar; zr = t; } }
            for (int idx = (sidx >= 36864 ? sidx - 36864 : sidx + 20480); idx < NG * 16 * NP; idx += NS) { const int g = idx >> 10, cch = (idx >> 6) & 15, p = idx & 63; const float* sc = SSMC + (size_t)(g * NP + p) * 8; const float ar = sc[4], ai = sc[5];
                const float cr = Cre[(size_t)(g * 16 + cch) * NP + p], ci = Cim[(size_t)(g * 16 + cch) * NP + p]; float zr = cr * ar - ci * ai, zi = cr * ai + ci * ar;
                for (int i = 0; i < CH; ++i) { bf16* d = TOEP + (size_t)(g * 512 + toep_col(i, cch)) * KY + KE; d[p] = (bf16)f2bf(zr); d[NP + p] = (bf16)f2bf(-zi);
                    const float t = zr * ar - zi * ai; zi = zr * ai + zi * ar; zr = t; } }
            for (int idx = sidx; idx < NG * 256 * 4; idx += NS) { const int pq = idx & 3, cc = (idx >> 2) & 255, g = idx >> 10, c1 = cc >> 4, c2 = cc & 15;
                float ks[CH];
#pragma unroll
                for (int l = 0; l < CH; ++l) ks[l] = 0.f;
                for (int pp = 0; pp < 16; ++pp) { const int p = pq * 16 + pp; const float* sc = SSMC + (size_t)(g * NP + p) * 8;
                    const float br = Bre[(size_t)(g * NP + p) * 16 + c2], bi = Bim[(size_t)(g * NP + p) * 16 + c2], bbr = sc[2] * br - sc[3] * bi, bbi = sc[2] * bi + sc[3] * br;
                    const float cr = Cre[(size_t)(g * 16 + c1) * NP + p], ci = Cim[(size_t)(g * 16 + c1) * NP + p]; float zr = cr * bbr - ci * bbi, zi = cr * bbi + ci * bbr; const float ar = sc[4], ai = sc[5];
#pragma unroll
                    for (int l = 0; l < CH; ++l) { ks[l] += zr; const float t = zr * ar - zi * ai; zi = zr * ai + zi * ar; zr = t; } }
#pragma unroll
                for (int l = 0; l < CH; ++l) { ks[l] += __shfl_xor(ks[l], 1); ks[l] += __shfl_xor(ks[l], 2); }
#pragma unroll
                for (int l = 0; l < CH; ++l) if ((l & 3) == pq) { const bf16 v = (bf16)f2bf(ks[l]);
                    for (int i = l; i < CH; ++i) TOEP[(size_t)(g * 512 + toep_col(i, c1)) * KY + (i - l) * 16 + c2] = v; } }
            for (int idx = sidx; idx < NG * 512 * CH; idx += NS) { const int g = idx >> 14, n = (idx >> 5) & 511, j = idx & 31; const int i = (n >> 8) * 16 + ((n >> 3) & 15);
                if (j > i) { bf16* d = TOEP + (size_t)(g * 512 + n) * KY + j * 16; const u32x4 z = {0u, 0u, 0u, 0u}; *(u32x4*)d = z; *(u32x4*)(d + 8) = z; } }
            }
        }
        idle_convert((unsigned*)(ws + WS_CTL), 1, G, true, args.in[29], args.in[30], args.in[31], WUP_T, WDN_T, lds, wave, lane, tid);
        if (BOTH(1)) GRID_BAR();
    }

    PHASE(2) {
        PH_IDS; (void)tid;
        if (c < 64) { Gemm g{UG, ETAB, KY, KE, KE}; SchedOne S; S.have = true; S.u0.pm = c; S.u0.pn = 0; S.u0.aoff = (long long)c * 256 * KY * 2; S.u0.boff = (long long)(c >> 1) * 128 * KE * 2;
            EpiScan E{UG, args.in[8], args.in[9], args.in[10]}; pg8::gemm_phase<EpiScan, SchedOne, false, true>(lds, g, S, E, wave); }
        else {
            const int ch = tid; float w[CWID];
#pragma unroll
            for (int k = 0; k < CWID; ++k) w[k] = args.in[4][k * DCONV + ch];
            const float bias = args.in[5][ch];
            LAS float* outl = (LAS float*)lds;
            for (int tile = c - 64; tile < T / 64; tile += G - 64) {
                const int t0 = tile * 64, tb0 = (t0 >> 13) << 13; float win[CWID];
                win[0] = 0.f;
#pragma unroll
                for (int i = 0; i < CWID - 1; ++i) { const int tt = t0 - (CWID - 1) + i; win[i + 1] = (tt >= tb0) ? bf2f(VBUF[(size_t)tt * 512 + ch]) : 0.f; }
                conv_block<31>(win, w, VBUF + (size_t)t0 * 512 + ch, bias, outl + ch);
                conv_block<31>(win, w, VBUF + (size_t)(t0 + 31) * 512 + ch, bias, outl + 31 * 512 + ch);
                conv_block<2>(win, w, VBUF + (size_t)(t0 + 62) * 512 + ch, bias, outl + 62 * 512 + ch);
                __syncthreads();
                for (int r = 0; r < 8; ++r) { const int tok = wave * 8 + r; float v[8]; float s = 0.f;
#pragma unroll
                    for (int j = 0; j < 8; ++j) { v[j] = outl[tok * 512 + lane + 64 * j]; s += v[j]; }
                    const float mean = wave_sum(s) * (1.f / 512.f); float q = 0.f;
#pragma unroll
                    for (int j = 0; j < 8; ++j) { v[j] -= mean; q += v[j] * v[j]; }
                    const float rstd = 1.0f / sqrtf(wave_sum(q) * (1.f / 512.f) + EPS);
#pragma unroll
                    for (int j = 0; j < 8; ++j) { const int cch = lane + 64 * j; const float o = v[j] * rstd * args.in[6][cch] + args.in[7][cch]; CONCAT[(size_t)(t0 + tok) * 1024 + cch] = (bf16)f2bf(o * sigmoidf_(o)); } }
                __syncthreads();
            }
        }
        idle_convert((unsigned*)(ws + WS_CTL), 2, G, true, args.in[29], args.in[30], args.in[31], WUP_T, WDN_T, lds, wave, lane, tid);
        if (BOTH(2)) GRID_BAR();
    }

    PHASE(3) {
        PH_IDS; (void)tid;
        if (c < 128) { const int g = c >> 2, b = (c >> 1) & 1, pn = c & 1; Gemm gm{UG, TOEP, KY, KY, KY}; SchedOne S; S.have = true; S.u0.pm = g * 2 + b; S.u0.pn = pn;
            S.u0.aoff = (long long)(g * 2 + b) * 256 * KY * 2; S.u0.boff = (long long)(g * 512 + pn * 256) * KY * 2;
            EpiY E{UG, args.in[15], GB}; pg8::gemm_phase<EpiY, SchedOne, true, true>(lds, gm, S, E, wave); }
        if (c >= 128 && c < 192) {
            const int L = c - 128, isv = L >> 5, b = (L >> 4) & 1, h = (L >> 2) & 3, qt = L & 3; SchedOne S; S.have = true;
            Gemm gm; if (!isv) { gm = Gemm{KVP, WQN, 2048, 1024, 256}; S.u0.pm = b * 4 + h; S.u0.pn = qt; S.u0.aoff = ((long long)b * 256 * 2048 + h * 256) * 2; S.u0.boff = ((long long)qt * 256 * 1024 + h * 256) * 2; }
            else { gm = Gemm{WO_T, KVP, 1024, 2048, 256}; S.u0.pm = b * 4 + qt; S.u0.pn = h; S.u0.aoff = ((long long)qt * 256 * 1024 + h * 256) * 2; S.u0.boff = ((long long)b * 256 * 2048 + 1024 + h * 256) * 2; }
            EpiBf E{isv ? VWOT : QKT, 1024}; pg8::gemm_phase<EpiBf, SchedOne, true, true>(lds, gm, S, E, wave); }
        idle_convert((unsigned*)(ws + WS_CTL), 3, G, true, args.in[29], args.in[30], args.in[31], WUP_T, WDN_T, lds, wave, lane, tid);
        if (BOTH(3)) GRID_BAR();
    }

    PHASE(4) {
        PH_IDS; (void)tid;
        { Gemm g{GB, GLUBT, 512, 128, 128}; SchedGrid S; S.nM = 64; S.nN = 4; S.G = G; S.c = c; S.atile = 256ll * 512 * 2; S.btile = 256ll * 128 * 2; S.acol = 128 * 2; S.bbatch = 0;
          EpiPair<0> E{CONCAT, 1024, 512}; pg8::gemm_phase<EpiPair<0>, SchedGrid, true, true>(lds, g, S, E, wave); }
        if (BOTH(4)) GRID_BAR();
    }

    PHASE(5) {
        PH_IDS; (void)tid;
        { Gemm g{CONCAT, WOUT_T, 1024, 1024, 1024}; SchedGrid S; S.nM = 64; S.nN = 4; S.G = G; S.c = c; S.atile = 256ll * 1024 * 2; S.btile = 256ll * 1024 * 2; S.acol = 0; S.bbatch = 0;
          EpiH1 E{X, OUT, H1B, RS1}; pg8::gemm_phase<EpiH1, SchedGrid, true, true>(lds, g, S, E, wave); }
        if (BOTH(5)) GRID_BAR();
    }

    PHASE(6) {
        PH_IDS; (void)tid;
        if (c < 256) {
            int pm, pn; pg8::static_unit(c, 64, 4, pm, pn); const int b = pm >> 5, h = pn;
            LAS float* rl = (LAS float*)(lds + EXT_OFF);
            for (int r = tid; r < 256; r += NTHR) { const float* p = RS1 + ((size_t)pm * 256 + r) * 16; float s = 0.f;
#pragma unroll
                for (int j = 0; j < 4; ++j) { const f32x4 v = *(const f32x4*)(p + 4 * j); s += (v[0] + v[1]) + (v[2] + v[3]); }
                rl[r] = 1.0f / sqrtf(s * (1.f / D) + EPS); }
            __syncthreads();
            SchedOne S; S.have = true; S.u0.pm = pm; S.u0.pn = pn;
            { Gemm g{H1B, QKT, 1024, 1024, 1024}; S.u0.aoff = (long long)pm * 256 * 1024 * 2; S.u0.boff = (long long)(b * 4 + h) * 256 * 1024 * 2;
              EpiSm E{PBUF, rl}; pg8::gemm_phase<EpiSm, SchedOne, false, true>(lds, g, S, E, wave); }
        }
        if (BOTH(6)) GRID_BAR();
    }

    PHASE(7) {
        PH_IDS; (void)tid;
        { Gemm g{PBUF, VWOT, 1024, 1024, 1024}; SchedGrid S; S.nM = 64; S.nN = 4; S.G = G; S.c = c; S.atile = 256ll * 1024 * 2; S.btile = 256ll * 1024 * 2; S.acol = 0; S.bbatch = 1024ll * 1024 * 2;
          EpiH2 E{OUT}; pg8::gemm_phase<EpiH2, SchedGrid, true, true>(lds, g, S, E, wave); }
        if (BOTH(7)) GRID_BAR();
    }

    PHASE(8) {
        PH_IDS; (void)tid;
        for (int blk = c; blk < T / 64; blk += G) {
            const int t0 = blk * 64;
            LAS float* Lp = (LAS float*)lds;
            LAS float* Sp = (LAS float*)(lds + 8 * 64 * 48 * 4);
            {
                f32x4 ac[4][3]; float ssq[4];
#pragma unroll
                for (int mb = 0; mb < 4; ++mb) { ssq[mb] = 0.f;
#pragma unroll
                    for (int nb = 0; nb < 3; ++nb) ac[mb][nb] = (f32x4){0.f, 0.f, 0.f, 0.f}; }
                const int fr = lane & 15, fq = lane >> 4;
#pragma unroll 1
                for (int st = 0; st < 4; ++st) { const int k0 = wave * 128 + st * 32 + 8 * fq;
                    bf16x8 bh[3], bl[3];
#pragma unroll
                    for (int nb = 0; nb < 3; ++nb) { bh[nb] = *(const bf16x8*)(WRH + (size_t)(nb * 16 + fr) * 1024 + k0); bl[nb] = *(const bf16x8*)(WRL + (size_t)(nb * 16 + fr) * 1024 + k0); }
#pragma unroll
                    for (int mb = 0; mb < 4; ++mb) { const float* xp = OUT + (size_t)(t0 + mb * 16 + fr) * 1024 + k0; const f32x4 x0 = *(const f32x4*)xp, x1 = *(const f32x4*)(xp + 4);
                        ssq[mb] += (x0[0] * x0[0] + x0[1] * x0[1]) + (x0[2] * x0[2] + x0[3] * x0[3]) + (x1[0] * x1[0] + x1[1] * x1[1]) + (x1[2] * x1[2] + x1[3] * x1[3]);
                        const u32x4 hw = pack8(x0, x1);
                        f32x4 r0, r1; r0[0] = x0[0] - bflo(hw.x); r0[1] = x0[1] - bfhi(hw.x); r0[2] = x0[2] - bflo(hw.y); r0[3] = x0[3] - bfhi(hw.y);
                        r1[0] = x1[0] - bflo(hw.z); r1[1] = x1[1] - bfhi(hw.z); r1[2] = x1[2] - bflo(hw.w); r1[3] = x1[3] - bfhi(hw.w);
                        const u32x4 lw = pack8(r0, r1);
                        const bf16x8 ah = __builtin_bit_cast(bf16x8, hw), al = __builtin_bit_cast(bf16x8, lw);
#pragma unroll
                        for (int nb = 0; nb < 3; ++nb) { ac[mb][nb] = __builtin_amdgcn_mfma_f32_16x16x32_bf16(ah, bh[nb], ac[mb][nb], 0, 0, 0);
                            ac[mb][nb] = __builtin_amdgcn_mfma_f32_16x16x32_bf16(al, bh[nb], ac[mb][nb], 0, 0, 0); ac[mb][nb] = __builtin_amdgcn_mfma_f32_16x16x32_bf16(ah, bl[nb], ac[mb][nb], 0, 0, 0); } } }
#pragma unroll
                for (int mb = 0; mb < 4; ++mb) { float sv = ssq[mb]; sv += __shfl_xor(sv, 16); sv += __shfl_xor(sv, 32); if (fq == 0) Sp[wave * 64 + mb * 16 + fr] = sv;
#pragma unroll
                    for (int nb = 0; nb < 3; ++nb)
#pragma unroll
                        for (int r = 0; r < 4; ++r) Lp[(wave * 64 + mb * 16 + 4 * fq + r) * 48 + nb * 16 + fr] = ac[mb][nb][r]; }
            }
            LAS float* Lg = (LAS float*)(lds + EXT_OFF + 1024);
            LAS int* lh = (LAS int*)(lds + EXT_OFF + 1024 + 64 * 40 * 4);
            if (tid < 32) lh[tid] = 0;
            __syncthreads();
            for (int idx = tid; idx < 64 * (NCOLR + 1); idx += NTHR) { const int tok = idx & 63, q = idx >> 6; float s = 0.f;
#pragma unroll
                for (int w8 = 0; w8 < 8; ++w8) s += (q < NCOLR) ? Lp[(w8 * 64 + tok) * 48 + q] : Sp[w8 * 64 + tok];
                Lg[tok * 40 + q] = s; }
            __syncthreads();
            if (tid < 64) { const int t = t0 + tid; const LAS float* L = Lg + tid * 40; const float rstd = 1.0f / sqrtf(L[NCOLR] * (1.f / D) + EPS); RSTD3[t] = rstd;
                float gl[4]; int gi = 0; float gm;
#pragma unroll
                for (int q = 0; q < 4; ++q) gl[q] = L[q] * rstd + args.in[26][q];
                gm = gl[0];
#pragma unroll
                for (int q = 1; q < 4; ++q) if (gl[q] > gm) { gm = gl[q]; gi = q; }
                float gs = 0.f;
#pragma unroll
                for (int q = 0; q < 4; ++q) gs += expf(gl[q] - gm);
                const float gwt = 1.0f / gs;
                float el[8];
#pragma unroll
                for (int q = 0; q < 8; ++q) el[q] = L[4 + gi * 8 + q] * rstd + args.in[28][gi * 8 + q];
                int i1 = 0; float l1 = el[0];
#pragma unroll
                for (int q = 1; q < 8; ++q) if (el[q] > l1) { l1 = el[q]; i1 = q; }
                int i2 = -1; float l2 = -3.0e38f;
#pragma unroll
                for (int q = 0; q < 8; ++q) if (q != i1 && el[q] > l2) { l2 = el[q]; i2 = q; }
                const float p2 = 1.0f / (1.0f + expf(l1 - l2)), p1 = 1.0f - p2;
                const int e1 = gi * 8 + i1, e2 = gi * 8 + i2;
                TOKE[t * 2] = e1; TOKE[t * 2 + 1] = e2; TOKG[t * 2] = gwt * p1; TOKG[t * 2 + 1] = gwt * p2;
                atomicAdd((int*)&lh[e1], 1); atomicAdd((int*)&lh[e2], 1); }
            __syncthreads();
            if (tid < 32) HIST[blk * 32 + tid] = lh[tid];
            __syncthreads();
        }
        idle_convert((unsigned*)(ws + WS_CTL), 8, G, false, args.in[29], args.in[30], args.in[31], WUP_T, WDN_T, lds, wave, lane, tid);
        if (BOTH(8)) GRID_BAR();
    }

    PHASE(9) {
        PH_IDS; (void)tid;
        for (int blk = c; blk < T / 64; blk += G) {
            const int t0 = blk * 64;
            LAS int* li = (LAS int*)lds; LAS int* cnt = li; LAS int* wgoff = li + 32; LAS int* base = li + 64; LAS int* lcnt = li + 96; LAS int* tpl = li + 128; LAS int* sl = li + 192;
            { LAS int* ptot = li + 512; LAS int* poff = li + 1024;
              const int e = tid & 31, part = tid >> 5; int total = 0, off = 0;
#pragma unroll
              for (int j = 0; j < 16; ++j) { const int w8 = part * 16 + j; const int hv = HIST[w8 * 32 + e]; total += hv; off += (w8 < blk) ? hv : 0; }
              ptot[part * 32 + e] = total; poff[part * 32 + e] = off;
              __syncthreads();
              if (tid < 32) { int tt = 0, oo = 0;
#pragma unroll
                  for (int j = 0; j < 16; ++j) { tt += ptot[j * 32 + tid]; oo += poff[j * 32 + tid]; }
                  cnt[tid] = tt; wgoff[tid] = oo; lcnt[tid] = 0; } }
            __syncthreads();
            if (tid == 0) { int a = 0; for (int e = 0; e < 32; ++e) { tpl[e] = a; base[e] = a * 256; a += (cnt[e] + 255) >> 8; } tpl[32] = a; }
            __syncthreads();
            if (blk == 0 && tid < 33) TPREF[tid] = tpl[tid];
            if (tid < 128) { const int tok = t0 + (tid >> 1), k = tid & 1; const int e = TOKE[tok * 2 + k]; const int rank = atomicAdd((int*)&lcnt[e], 1); const int slot = base[e] + wgoff[e] + rank;
                TOKS[tok * 2 + k] = slot; SGATE[slot] = TOKG[tok * 2 + k]; sl[tid] = slot; }
            __syncthreads();
            for (int r = 0; r < 8; ++r) { const int tl = wave * 8 + r, tok = t0 + tl; const int s0 = sl[tl * 2], s1 = sl[tl * 2 + 1]; const float rstd = RSTD3[tok];
#pragma unroll
                for (int j = 0; j < 4; ++j) { const int col = (lane + 64 * j) * 4; const f32x4 v = *(const f32x4*)(OUT + (size_t)tok * 1024 + col), gn = *(const f32x4*)(args.in[24] + col);
                    u32x2 o; o.x = pk2(v[0] * rstd * gn[0], v[1] * rstd * gn[1]); o.y = pk2(v[2] * rstd * gn[2], v[3] * rstd * gn[3]);
                    *(u32x2*)(XG + (size_t)s0 * 1024 + col) = o; *(u32x2*)(XG + (size_t)s1 * 1024 + col) = o; } }
            __syncthreads();
        }
        if (BOTH(9)) GRID_BAR();
    }

    PHASE(10) {
        PH_IDS; (void)tid;
        volatile LAS int* tp = (volatile LAS int*)(lds + EXT_OFF + 8192);
        if (tid < 33) tp[tid] = TPREF[tid];
        __syncthreads();
        { Gemm g{XG, WUP_T, 1024, 1024, 1024}; SchedMoe S; S.tp = tp; S.G = G; S.c = c; S.atile = 256ll * 1024 * 2; S.bexp = 1024ll * 1024 * 2; S.btile = 256ll * 1024 * 2;
          EpiPair<1> E{HID, 512, 0}; pg8::gemm_phase<EpiPair<1>, SchedMoe, true, true>(lds, g, S, E, wave); }
        if (BOTH(10)) GRID_BAR();
    }

    PHASE(11) {
        PH_IDS; (void)tid;
        volatile LAS int* tp = (volatile LAS int*)(lds + EXT_OFF + 8192);
        if (tid < 33) tp[tid] = TPREF[tid];
        __syncthreads();
        { Gemm g{HID, WDN_T, 512, 512, 512}; SchedMoe S; S.tp = tp; S.G = G; S.c = c; S.atile = 256ll * 512 * 2; S.bexp = 1024ll * 512 * 2; S.btile = 256ll * 512 * 2;
          EpiDown E{XG, SGATE}; pg8::gemm_phase<EpiDown, SchedMoe, true, true>(lds, g, S, E, wave); }
        if (BOTH(11)) GRID_BAR();
    }

    PHASE(12) {
        PH_IDS; (void)tid;
        int ns0 = TOKS[gw * 2], ns1 = TOKS[gw * 2 + 1];
        for (int tok = gw; tok < T; tok += NGW) { const int s0 = ns0, s1 = ns1; if (tok + NGW < T) { ns0 = TOKS[(tok + NGW) * 2]; ns1 = TOKS[(tok + NGW) * 2 + 1]; } f32x4 v[4]; float ss = 0.f;
#pragma unroll
            for (int j = 0; j < 4; ++j) { const int col = (lane + 64 * j) * 4; v[j] = *(const f32x4*)(OUT + (size_t)tok * 1024 + col);
                const u32x2 a = *(const u32x2*)(XG + (size_t)s0 * 1024 + col), b2 = *(const u32x2*)(XG + (size_t)s1 * 1024 + col);
                v[j][0] += bflo(a.x) + bflo(b2.x); v[j][1] += bfhi(a.x) + bfhi(b2.x); v[j][2] += bflo(a.y) + bflo(b2.y); v[j][3] += bfhi(a.y) + bfhi(b2.y);
                ss += (v[j][0] * v[j][0] + v[j][1] * v[j][1]) + (v[j][2] * v[j][2] + v[j][3] * v[j][3]); }
            const float r = 1.0f / sqrtf(wave_sum(ss) * (1.f / D) + EPS);
#pragma unroll
            for (int j = 0; j < 4; ++j) { const int col = (lane + 64 * j) * 4; const f32x4 gn = *(const f32x4*)(args.in[32] + col); *(f32x4*)(OUT + (size_t)tok * 1024 + col) = v[j] * r * gn; } }
    }
#undef IN
#undef BOTH
#undef GRID_BAR
}

#ifndef PROBE_K
#define PROBE_K -1
#endif
extern "C" void kernel_launch(void* const* d_in, const int* in_sizes, int n_in, void* d_out, int out_size, void* d_ws, size_t ws_size, hipStream_t stream) {
    static int grid = 0;
    if (grid == 0) {
        if (n_in != 33 || in_sizes[0] != T * D || out_size != T * D || ws_size < WS_END) { fprintf(stderr, "kernel_launch: unexpected shapes (n_in %d, in0 %d, out %d, ws %zu); nothing launched\n", n_in, n_in > 0 ? in_sizes[0] : -1, out_size, ws_size); grid = -1; return; }
        int dev = 0, cus = 0, per_cu = 0;
        if (hipGetDevice(&dev) != hipSuccess || hipDeviceGetAttribute(&cus, hipDeviceAttributeMultiprocessorCount, dev) != hipSuccess) { grid = -1; return; }
        if (hipFuncSetAttribute((const void*)mk_fwd, hipFuncAttributeMaxDynamicSharedMemorySize, LDS_BYTES) != hipSuccess) { fprintf(stderr, "kernel_launch: hipFuncSetAttribute failed\n"); grid = -1; return; }
        if (hipOccupancyMaxActiveBlocksPerMultiprocessor(&per_cu, (const void*)mk_fwd, NTHR, LDS_BYTES) != hipSuccess || per_cu < 1) fprintf(stderr, "kernel_launch: note: occupancy query reports %d\n", per_cu);
        (void)hipGetLastError();
        grid = cus;
        if (grid != 256) { fprintf(stderr, "kernel_launch: built for a 256-CU device, got %d CUs; nothing launched\n", grid); grid = -1; return; }
    }
    if (grid < 0) return;
    if (hipMemsetAsync((char*)d_ws + WS_CTL, 0, CTL_ZERO_BYTES, stream) != hipSuccess) return;
    Args a{};
    for (int i = 0; i < 33; ++i) a.in[i] = (const float*)d_in[i];
    a.out = (float*)d_out; a.ws = (unsigned char*)d_ws;
#if MK_PER_PHASE
    for (int ph = 0; ph < NPHASE; ++ph) { a.ph_lo = ph; a.ph_hi = ph + 1; hipLaunchKernelGGL(mk_fwd, dim3(grid), dim3(NTHR), LDS_BYTES, stream, a); }
#else
#if PROBE_K >= 0
    a.ph_lo = 0; a.ph_hi = PROBE_K + 1; hipLaunchKernelGGL(mk_fwd, dim3(grid), dim3(NTHR), LDS_BYTES, stream, a);
    (void)hipMemsetAsync((char*)d_ws + WS_CTL, 0, CTL_ZERO_BYTES, stream);
    a.ph_lo = PROBE_K; a.ph_hi = NPHASE; hipLaunchKernelGGL(mk_fwd, dim3(grid), dim3(NTHR), LDS_BYTES, stream, a);
#else
    a.ph_lo = 0; a.ph_hi = NPHASE; hipLaunchKernelGGL(mk_fwd, dim3(grid), dim3(NTHR), LDS_BYTES, stream, a);
#endif
#endif
}
```
